# Optimizing an MI355X kernel written in HIP

```python
import jax, jax.numpy as jnp
from jax import lax
import numpy as np

D_MODEL = 1024
BATCH = 32
SEQ = 256
DEPTH = 1
DEC_BATCH = 4
DEC_SEQ = 2048
PAST_LEN = 256

GRID_W = 64
GLA_HEADS = 4
GLA_DK = D_MODEL // 16
GLA_DV = D_MODEL // 8
GLA_LOWRANK = 16
GLA_GATE_NORM = 16.0
HGRN_HEADS = 4
HGRN_EXPAND = D_MODEL // 8
HGRN_DV = D_MODEL // 8
GLA_KW = GLA_HEADS * GLA_DK
GLA_VW = GLA_HEADS * GLA_DV
HGRN_KW = HGRN_HEADS * HGRN_EXPAND
HGRN_VW = HGRN_HEADS * HGRN_DV
IN_SIZES = (GLA_KW, GLA_KW, GLA_VW, GLA_VW, 2 * GLA_LOWRANK, HGRN_KW, 2 * HGRN_KW, HGRN_VW, HGRN_VW)
IN_WIDTH = GLA_KW * 2 + GLA_VW * 2 + 2 * GLA_LOWRANK + HGRN_KW * 3 + HGRN_VW * 2
FFN_HIDDEN = ((8 * D_MODEL // 3 + 127) // 128) * 128
CONV_W = 3
CHUNK = 16
EPS = 1e-6

kernel_name = 'hybrid_gla_hgrn2_diffusion_step'


def rmsnorm(x, g):
    xf = x.astype(jnp.float32)
    y = xf * lax.rsqrt(jnp.mean(xf * xf, axis=-1, keepdims=True) + EPS)
    return (y * g.astype(jnp.float32)).astype(x.dtype)


def chunk_gated_linear(q, k, v, log_f, s0):
    B, H, T, DK = q.shape
    DV = v.shape[-1]
    N = T // CHUNK
    f32 = jnp.float32
    q = q.astype(f32).reshape(B, H, N, CHUNK, DK)
    k = k.astype(f32).reshape(B, H, N, CHUNK, DK)
    v = v.astype(f32).reshape(B, H, N, CHUNK, DV)
    b = jnp.cumsum(log_f.astype(f32).reshape(B, H, N, CHUNK, DK), axis=3)
    b_last = b[:, :, :, -1:, :]
    lower = jnp.tril(jnp.ones((CHUNK, CHUNK), dtype=bool))[:, :, None]
    rel = b[:, :, :, :, None, :] - b[:, :, :, None, :, :]
    decay = jnp.exp(jnp.where(lower, rel, -jnp.inf))
    scores = jnp.einsum('bhnid,bhnijd,bhnjd->bhnij', q, decay, k)
    o_intra = jnp.einsum('bhnij,bhnjv->bhniv', scores, v)
    q_in = q * jnp.exp(b)
    k_out = k * jnp.exp(b_last - b)
    f_chunk = jnp.exp(b_last[:, :, :, 0, :])

    def step(S, xs):
        qc, kc, vc, fc = xs
        o = jnp.einsum('bhcd,bhdv->bhcv', qc, S)
        S = fc[..., None] * S + jnp.einsum('bhcd,bhcv->bhdv', kc, vc)
        return S, o

    xs = (jnp.moveaxis(q_in, 2, 0), jnp.moveaxis(k_out, 2, 0), jnp.moveaxis(v, 2, 0), jnp.moveaxis(f_chunk, 2, 0))
    s_final, o_inter = lax.scan(step, s0.astype(f32), xs)
    o = o_intra + jnp.moveaxis(o_inter, 0, 2)
    return o.reshape(B, H, T, DV), s_final


def bidir_scan(q, k_fwd, k_bwd, v, logf_fwd, logf_bwd, s0_fwd, s0_bwd):
    flip = lambda t: jnp.flip(t, axis=2)
    o_f, s_f = chunk_gated_linear(q, k_fwd, v, logf_fwd, s0_fwd)
    o_b, s_b = chunk_gated_linear(flip(q), flip(k_bwd), flip(v), flip(logf_bwd), s0_bwd)
    return o_f + flip(o_b), s_f, s_b


def to_heads(t, n):
    B, T, W = t.shape
    return t.reshape(B, T, n, W // n).transpose(0, 2, 1, 3)


def hybrid_mixer(h, s_gla, s_hgrn, w_in, w_gla_up, b_gla, lb, gla_norm, hgrn_norm, w_out):
    B, T, _ = h.shape
    offsets = np.cumsum(IN_SIZES)[:-1].tolist()
    q_a, k_a, v_a, g_a, lr_a, q_b, f_b, i_b, g_b = jnp.split(h @ w_in, offsets, axis=-1)
    lr = lr_a.reshape(B, T, 2, GLA_LOWRANK)
    alpha_logit = jnp.einsum('btdr,drk->dbtk', lr, w_gla_up) + b_gla[:, None, None, :]
    log_alpha = jax.nn.log_sigmoid(alpha_logit.astype(jnp.float32)) / GLA_GATE_NORM
    qa = to_heads(q_a, GLA_HEADS) * (GLA_DK ** -0.5)
    ka = to_heads(k_a, GLA_HEADS)
    va = to_heads(v_a, GLA_HEADS)
    o_a, sa_f, sa_b = bidir_scan(qa, ka, ka, va, to_heads(log_alpha[0], GLA_HEADS), to_heads(log_alpha[1], GLA_HEADS), s_gla[:, 0], s_gla[:, 1])
    o_a = rmsnorm(o_a.transpose(0, 2, 1, 3).astype(h.dtype), gla_norm) * jax.nn.silu(g_a).reshape(B, T, GLA_HEADS, GLA_DV)
    f_raw = f_b.reshape(B, T, 2, HGRN_KW).astype(jnp.float32)
    log_f = jnp.logaddexp(jnp.log(lb), jnp.log1p(-lb) + jax.nn.log_sigmoid(f_raw))
    i_gate = -jnp.expm1(log_f)
    qb = to_heads(q_b, HGRN_HEADS)
    vb = to_heads(i_b, HGRN_HEADS)
    o_h, sb_f, sb_b = bidir_scan(qb, to_heads(i_gate[:, :, 0], HGRN_HEADS), to_heads(i_gate[:, :, 1], HGRN_HEADS), vb, to_heads(log_f[:, :, 0], HGRN_HEADS), to_heads(log_f[:, :, 1], HGRN_HEADS), s_hgrn[:, 0], s_hgrn[:, 1])
    o_h = rmsnorm(o_h.transpose(0, 2, 1, 3).astype(h.dtype), hgrn_norm) * jax.nn.silu(g_b).reshape(B, T, HGRN_HEADS, HGRN_DV)
    merged = jnp.concatenate([o_a.reshape(B, T, GLA_VW), o_h.reshape(B, T, HGRN_VW)], axis=-1)
    new_gla = jnp.stack([sa_f, sa_b], axis=1).astype(s_gla.dtype)
    new_hgrn = jnp.stack([sb_f, sb_b], axis=1).astype(s_hgrn.dtype)
    return merged @ w_out, new_gla, new_hgrn


def dw_conv(u, conv_w, conv_b, grid):
    B, T, C = u.shape
    if grid:
        rows = T // GRID_W
        img = u.reshape(B, rows, GRID_W, C)
        out = lax.conv_general_dilated(img, conv_w[:, :, None, :], (1, 1), 'SAME', dimension_numbers=('NHWC', 'HWIO', 'NHWC'), feature_group_count=C)
        out = out.reshape(B, T, C)
    else:
        out = lax.conv_general_dilated(u, conv_w[CONV_W // 2][:, None, :], (1,), 'SAME', dimension_numbers=('NWC', 'WIO', 'NWC'), feature_group_count=C)
    return out + conv_b


def conv_ffn(h, w_up, conv_w, conv_b, w_down, grid):
    u = dw_conv(h @ w_up, conv_w, conv_b, grid)
    gate, up = jnp.split(u, 2, axis=-1)
    return (jax.nn.silu(gate) * up) @ w_down


def trunk_layer(x, mod, s_gla, s_hgrn, norm1, norm2, w_in, w_gla_up, b_gla, lb, gla_norm, hgrn_norm, w_out, w_ffn_up, ffn_conv, b_ffn_conv, w_ffn_down, grid):
    shift1, scale1, gate1, shift2, scale2, gate2 = jnp.split(mod, 6, axis=-1)
    h = rmsnorm(x, norm1) * (1 + scale1) + shift1
    mix, new_gla, new_hgrn = hybrid_mixer(h, s_gla, s_hgrn, w_in, w_gla_up, b_gla, lb, gla_norm, hgrn_norm, w_out)
    x = x + gate1 * mix
    h = rmsnorm(x, norm2) * (1 + scale2) + shift2
    x = x + gate2 * conv_ffn(h, w_ffn_up, ffn_conv, b_ffn_conv, w_ffn_down, grid)
    return x, new_gla, new_hgrn


def setup_inputs(seed: int = 0) -> dict:
    key = jax.random.key(seed)
    ks = jax.random.split(key, 24)
    n = lambda i, shape: jax.random.normal(ks[i], shape, jnp.float32)
    return {
        'x_prompt': n(0, (BATCH, SEQ, D_MODEL)),
        'x_sample': n(1, (DEC_BATCH, DEC_SEQ, D_MODEL)),
        'state_gla': 0.5 * n(2, (DEC_BATCH, DEPTH, 2, GLA_HEADS, GLA_DK, GLA_DV)),
        'state_hgrn': 0.5 * n(3, (DEC_BATCH, DEPTH, 2, HGRN_HEADS, HGRN_EXPAND, HGRN_DV)),
        'c': n(4, (DEC_BATCH, D_MODEL)),
        'c_ctx': n(5, (D_MODEL,)),
        'w_ada': 0.5 * D_MODEL ** -0.5 * n(6, (DEPTH, D_MODEL, 6 * D_MODEL)),
        'b_ada': 0.02 * n(7, (DEPTH, 6 * D_MODEL)),
        'norm1': 1.0 + 0.02 * n(8, (DEPTH, D_MODEL)),
        'norm2': 1.0 + 0.02 * n(9, (DEPTH, D_MODEL)),
        'w_in': D_MODEL ** -0.5 * n(10, (DEPTH, D_MODEL, IN_WIDTH)),
        'w_gla_up': GLA_LOWRANK ** -0.5 * n(11, (DEPTH, 2, GLA_LOWRANK, GLA_KW)),
        'b_gla': 0.1 * n(12, (DEPTH, 2, GLA_KW)),
        'hgrn_lb': 0.5 * n(13, (DEPTH + 1, 2, HGRN_KW)),
        'gla_norm': 1.0 + 0.02 * n(14, (DEPTH, GLA_DV)),
        'hgrn_norm': 1.0 + 0.02 * n(15, (DEPTH, HGRN_DV)),
        'w_out': D_MODEL ** -0.5 * n(16, (DEPTH, D_MODEL, D_MODEL)),
        'w_ffn_up': D_MODEL ** -0.5 * n(17, (DEPTH, D_MODEL, 2 * FFN_HIDDEN)),
        'ffn_conv': (CONV_W * CONV_W) ** -0.5 * n(18, (DEPTH, CONV_W, CONV_W, 2 * FFN_HIDDEN)),
        'b_ffn_conv': 0.02 * n(19, (DEPTH, 2 * FFN_HIDDEN)),
        'w_ffn_down': FFN_HIDDEN ** -0.5 * n(20, (DEPTH, FFN_HIDDEN, D_MODEL)),
        'final_norm': 1.0 + 0.02 * n(21, (D_MODEL,)),
    }


def reference(x_prompt, x_sample, state_gla, state_hgrn, c, c_ctx, w_ada, b_ada, norm1, norm2, w_in, w_gla_up, b_gla, hgrn_lb, gla_norm, hgrn_norm, w_out, w_ffn_up, ffn_conv, b_ffn_conv, w_ffn_down, final_norm):
    lb_all = jnp.cumsum(jax.nn.softmax(hgrn_lb.astype(jnp.float32), axis=0), axis=0)
    bp = x_prompt.shape[0]
    zero_gla = jnp.zeros((bp, 2, GLA_HEADS, GLA_DK, GLA_DV), state_gla.dtype)
    zero_hgrn = jnp.zeros((bp, 2, HGRN_HEADS, HGRN_EXPAND, HGRN_DV), state_hgrn.dtype)
    xp, xs = x_prompt, x_sample
    gla_states, hgrn_states = [], []
    for l in range(DEPTH):
        mod_ctx = (jax.nn.silu(c_ctx) @ w_ada[l] + b_ada[l])[None, None, :]
        mod_lat = (jax.nn.silu(c) @ w_ada[l] + b_ada[l])[:, None, :]
        layer_w = (norm1[l], norm2[l], w_in[l], w_gla_up[l], b_gla[l], lb_all[l], gla_norm[l], hgrn_norm[l], w_out[l], w_ffn_up[l], ffn_conv[l], b_ffn_conv[l], w_ffn_down[l])
        xp, sg, sh = trunk_layer(xp, mod_ctx, zero_gla, zero_hgrn, *layer_w, grid=False)
        gla_states.append(sg)
        hgrn_states.append(sh)
        xs, _, _ = trunk_layer(xs, mod_lat, state_gla[:, l], state_hgrn[:, l], *layer_w, grid=True)
    y_prompt = rmsnorm(xp, final_norm)
    y_sample = rmsnorm(xs, final_norm)
    new_state_gla = jnp.stack(gla_states, axis=1)
    new_state_hgrn = jnp.stack(hgrn_states, axis=1)
    return (y_prompt, y_sample, new_state_gla, new_state_hgrn)
```

```cpp
#include <hip/hip_runtime.h>
#include <hip/hip_cooperative_groups.h>
#include <cstdio>
#include <cstdint>
namespace cg = cooperative_groups;
#ifndef MK_MULTI
#define MK_MULTI 0
#endif
namespace pg8 {
#define PG8_LAS __attribute__((address_space(3)))
typedef unsigned short bf16_t;
typedef short bf16x8 __attribute__((ext_vector_type(8)));
typedef float f32x4 __attribute__((ext_vector_type(4)));
typedef unsigned u32x4 __attribute__((ext_vector_type(4)));
typedef unsigned u32x2 __attribute__((ext_vector_type(2)));
constexpr int BM = 256, BK = 64, HALF = 128, HTB = HALF * BK * 2  , STAGE_BYTES = 8 * HTB, NXCD = 8, WGM = 8;

__host__ __device__ __forceinline__ int lds_byte(int r, int c) { const int st = (r >> 4) * 2 + (c >> 5), rr = r & 15, cc = c & 31, ob = rr * 64 + cc * 2; return st * 1024 + (ob ^ (((ob >> 9) & 1) << 5)); }
__host__ __device__ __forceinline__ void stage_rc(int b, int& R, int& C) { const int st = b / 1024, sb = b % 1024, swz = sb ^ (((sb >> 9) & 1) << 5); R = (st >> 1) * 16 + swz / 64; C = (st & 1) * 32 + (swz % 64) / 2; }
__host__ __device__ __forceinline__ int perm32(int rho) { const int n = rho >> 4, i = rho & 15; return 8 * (i >> 2) + 4 * n + (i & 3); }

struct Unit { int pm, pn; };
struct Gemm { const bf16_t* A; const bf16_t* Bt; int M, N, K; };

struct StaticOrder {
    int nM, nN, nwg, G, c;
    __host__ __device__ void init(int M, int N, int G_, int c_) { nM = M / BM; nN = N / BM; nwg = nM * nN; G = G_; c = c_; }
    __host__ __device__ bool next(int i, Unit& u) const {
        const long L = (long)i * G + c; if (L >= nwg) return false;
        int wgid = (int)L; { const int q = nwg / NXCD, r = nwg % NXCD, xcd = wgid % NXCD, off = wgid / NXCD; wgid = (xcd < r ? xcd * (q + 1) : r * (q + 1) + (xcd - r) * q) + off; }
        const int nig = WGM * nN, gid = wgid / nig, fm = gid * WGM, gsz = (nM - fm) < WGM ? (nM - fm) : WGM;
        u.pm = fm + ((wgid % nig) % gsz); u.pn = (wgid % nig) / gsz; return true;
    }
    __device__ __forceinline__ void a_ready(const Unit&) const {}
    __device__ __forceinline__ void done(const Unit&) const {}
};

__device__ __forceinline__ unsigned cvt_pk_bf16(float lo, float hi) { unsigned r; asm volatile("v_cvt_pk_bf16_f32 %0, %1, %2" : "=v"(r) : "v"(lo), "v"(hi)); return r; }
typedef float f32x2 __attribute__((ext_vector_type(2)));
typedef float f32x2_t __attribute__((ext_vector_type(2))); typedef __bf16 bf16x2_t __attribute__((ext_vector_type(2)));
__device__ __forceinline__ unsigned cvtpk(float lo, float hi) { f32x2_t v = {lo, hi}; bf16x2_t b = __builtin_convertvector(v, bf16x2_t); return __builtin_bit_cast(unsigned, b); }
__device__ __forceinline__ float fast_exp(float x) { return __builtin_amdgcn_exp2f(x * 1.4426950408889634f); }
__device__ __forceinline__ float fast_log(float x) { return __builtin_amdgcn_logf(x) * 0.6931471805599453f; }
__device__ __forceinline__ float fast_rcp(float x) { return __builtin_amdgcn_rcpf(x); }
__device__ __forceinline__ float silu_f(float x) { return x * fast_rcp(1.f + fast_exp(-x)); }

struct EpiPlain {
    static constexpr bool PERM = true, AFTER_DRAIN = false;
    bf16_t* O; int ldc;
    __device__ __forceinline__ void operator()(const f32x4 (&acc)[2][2][4][2], const Unit& u, int wr, int wc, int fr, int fq) const {
        const int row0 = u.pm * BM + wr * 64 + fr, col0 = u.pn * BM + wc * 32 + 8 * fq;
#pragma unroll
        for (int ai = 0; ai < 2; ++ai)
#pragma unroll
            for (int m = 0; m < 4; ++m) { bf16_t* rowp = O + (size_t)(row0 + ai * HALF + m * 16) * ldc + col0;
#pragma unroll
                for (int bj = 0; bj < 2; ++bj) { const f32x4 v0 = acc[ai][bj][m][0], v1 = acc[ai][bj][m][1];
                    u32x4 w; w.x = cvtpk(v0[0], v0[1]); w.y = cvtpk(v0[2], v0[3]); w.z = cvtpk(v1[0], v1[1]); w.w = cvtpk(v1[2], v1[3]);
                    *(u32x4*)(rowp + bj * HALF) = w; } }
    }
};
struct EpiProj {
    static constexpr bool PERM = true, AFTER_DRAIN = false;
    bf16_t* O; const float* c0; const float* c1;
    __device__ __forceinline__ void operator()(const f32x4 (&acc)[2][2][4][2], const Unit& u, int wr, int wc, int fr, int fq) const {
        const int row0 = u.pm * BM + wr * 64 + fr; const int pn = u.pn;
        const int kind = (pn == 0) ? 1 : ((pn == 4 || pn == 5 || pn == 14 || pn == 15) ? 2 : ((pn >= 8 && pn <= 11) ? 3 : (pn >= 16 ? 4 : 0)));
#pragma unroll
        for (int bj = 0; bj < 2; ++bj) {
            const int col = pn * BM + bj * HALF + wc * 32 + 8 * fq;
            f32x4 ca0 = {0.f, 0.f, 0.f, 0.f}, ca1 = ca0, cb0 = ca0, cb1 = ca0;
            if (kind >= 3) { ca0 = *(const f32x4*)(c0 + col); ca1 = *(const f32x4*)(c0 + col + 4); }
            if (kind == 3) { cb0 = *(const f32x4*)(c1 + col); cb1 = *(const f32x4*)(c1 + col + 4); }
#pragma unroll
            for (int ai = 0; ai < 2; ++ai)
#pragma unroll
                for (int m = 0; m < 4; ++m) {
                    f32x4 v0 = acc[ai][bj][m][0], v1 = acc[ai][bj][m][1];
                    if (kind == 1) { v0 = v0 * 0.125f; v1 = v1 * 0.125f; }
                    else if (kind == 2) {
#pragma unroll
                        for (int e = 0; e < 4; ++e) { v0[e] = silu_f(v0[e]); v1[e] = silu_f(v1[e]); } }
                    else if (kind == 3) {
#pragma unroll
                        for (int e = 0; e < 4; ++e) { v0[e] = fast_log(ca0[e] + cb0[e] * fast_rcp(1.f + fast_exp(-v0[e]))); v1[e] = fast_log(ca1[e] + cb1[e] * fast_rcp(1.f + fast_exp(-v1[e]))); } }
                    else if (kind == 4) {
#pragma unroll
                        for (int e = 0; e < 4; ++e) { v0[e] = -0.0625f * fast_log(1.f + fast_exp(-(v0[e] + ca0[e]))); v1[e] = -0.0625f * fast_log(1.f + fast_exp(-(v1[e] + ca1[e]))); } }
                    u32x4 w; w.x = cvtpk(v0[0], v0[1]); w.y = cvtpk(v0[2], v0[3]); w.z = cvtpk(v1[0], v1[1]); w.w = cvtpk(v1[2], v1[3]);
                    *(u32x4*)(O + (size_t)(row0 + ai * HALF + m * 16) * 4608 + col) = w;
                }
        }
    }
};
struct EpiRes {
    static constexpr bool PERM = false, AFTER_DRAIN = false;
    const float* base0; const float* base1; float* out; const float* gate;
    __device__ __forceinline__ void operator()(const f32x4 (&acc)[2][2][4][2], const Unit& u, int wr, int wc, int fr, int fq) const {
        const int rt = u.pm * BM;
        const float* base = rt < 8192 ? base0 + (size_t)rt * 1024 : base1 + (size_t)(rt - 8192) * 1024;
        const float* g = gate + (rt < 8192 ? 0 : 1 + ((rt - 8192) >> 11)) * 6144;
        float* o = out + (size_t)rt * 1024;
        const int col0 = u.pn * BM + wc * 32 + 4 * fq;
#pragma unroll
        for (int bj = 0; bj < 2; ++bj)
#pragma unroll
            for (int n = 0; n < 2; ++n) { const int col = col0 + bj * HALF + n * 16; const f32x4 g4 = *(const f32x4*)(g + col);
#pragma unroll
                for (int ai = 0; ai < 2; ++ai)
#pragma unroll
                    for (int m = 0; m < 4; ++m) { const size_t off = (size_t)(ai * HALF + wr * 64 + m * 16 + fr) * 1024 + col;
                        const f32x4 b = *(const f32x4*)(base + off); *(f32x4*)(o + off) = b + g4 * acc[ai][bj][m][n]; } }
    }
};

template <bool FINAL> struct EpiResNorm {
    static constexpr bool PERM = false, AFTER_DRAIN = true;
    static constexpr int LROW = 260;
    const float* base0; const float* base1; float* out; const float* mod; int gate_off, shift_off, scale_off; const float* gvec; bf16_t* XN; float* slots; unsigned* cnt;
    __device__ __forceinline__ void fused(f32x4 (&acc)[2][2][4][2], const Unit& u, int wr, int wc, int fr, int fq, PG8_LAS unsigned char* lds, int wid, int lane) const {
        const int rt = u.pm * BM;
        const float* base = rt < 8192 ? base0 + (size_t)rt * 1024 : base1 + (size_t)(rt - 8192) * 1024;
        const float* mv = mod + (rt < 8192 ? 0 : 1 + ((rt - 8192) >> 11)) * 6144;
        float* o = out + (size_t)rt * 1024;
        const int col0 = u.pn * BM + wc * 32 + 4 * fq;
        PG8_LAS float* T = (PG8_LAS float*)lds;
        PG8_LAS float* Pp = T + 128 * LROW; PG8_LAS float* Sr = Pp + 1024;
        const int lbase = (wr * 64 + fr) * LROW + wc * 32 + 4 * fq;
        float ss[2][4];
#pragma unroll
        for (int ai = 0; ai < 2; ++ai)
#pragma unroll
            for (int m = 0; m < 4; ++m) ss[ai][m] = 0.f;
#pragma unroll
        for (int bj = 0; bj < 2; ++bj)
#pragma unroll
            for (int n = 0; n < 2; ++n) { const int col = col0 + bj * HALF + n * 16; const f32x4 g4 = *(const f32x4*)(mv + gate_off + col);
                f32x4 bv[2][4];
#pragma unroll
                for (int ai = 0; ai < 2; ++ai)
#pragma unroll
                    for (int m = 0; m < 4; ++m) bv[ai][m] = *(const f32x4*)(base + (size_t)(ai * HALF + wr * 64 + m * 16 + fr) * 1024 + col);
#pragma unroll
                for (int ai = 0; ai < 2; ++ai)
#pragma unroll
                    for (int m = 0; m < 4; ++m) { const size_t off = (size_t)(ai * HALF + wr * 64 + m * 16 + fr) * 1024 + col;
                        const f32x4 v = bv[ai][m] + g4 * acc[ai][bj][m][n];
                        if (!FINAL) *(f32x4*)(o + off) = v;
                        ss[ai][m] += (v[0] * v[0] + v[1] * v[1]) + (v[2] * v[2] + v[3] * v[3]);
                        if (ai == 0) *(PG8_LAS f32x4*)(T + lbase + m * 16 * LROW + bj * HALF + n * 16) = v; else acc[1][bj][m][n] = v; } }
#pragma unroll
        for (int ai = 0; ai < 2; ++ai)
#pragma unroll
            for (int m = 0; m < 4; ++m) { float s = ss[ai][m]; s += __shfl_xor(s, 16); s += __shfl_xor(s, 32);
                if (fq == 0) Pp[(ai * HALF + wr * 64 + m * 16 + fr) * 4 + wc] = s; }
        __syncthreads();
        const int tid = wid * 64 + lane;
        if (tid < 256) { const f32x4 p = *(const PG8_LAS f32x4*)(Pp + tid * 4);
            __hip_atomic_store(slots + (size_t)(rt + tid) * 4 + u.pn, (p[0] + p[1]) + (p[2] + p[3]), __ATOMIC_RELAXED, __HIP_MEMORY_SCOPE_AGENT); }
        asm volatile("s_waitcnt vmcnt(0)" ::: "memory");
        __syncthreads();
        if (tid == 0) { unsigned* c = cnt + 64 * u.pm; __hip_atomic_fetch_add(c, 1u, __ATOMIC_RELAXED, __HIP_MEMORY_SCOPE_AGENT);
            for (unsigned sp = 0; sp < (1u << 24); ++sp) { if (__hip_atomic_load(c, __ATOMIC_RELAXED, __HIP_MEMORY_SCOPE_AGENT) >= 4u) break; __builtin_amdgcn_s_sleep(1); } }
        __syncthreads();
        if (tid < 256) { float t = 0.f;
#pragma unroll
            for (int q = 0; q < 4; ++q) t += __hip_atomic_load(slots + (size_t)(rt + tid) * 4 + q, __ATOMIC_RELAXED, __HIP_MEMORY_SCOPE_AGENT);
            Sr[tid] = rsqrtf(t * (1.f / 1024.f) + 1e-6f); }
        __syncthreads();
#pragma unroll
        for (int bj = 0; bj < 2; ++bj)
#pragma unroll
            for (int n = 0; n < 2; ++n) { const int col = col0 + bj * HALF + n * 16; const f32x4 gg = *(const f32x4*)(gvec + col);
                f32x4 sc = {0.f, 0.f, 0.f, 0.f}, sh = sc; if (!FINAL) { sc = *(const f32x4*)(mv + scale_off + col) + 1.f; sh = *(const f32x4*)(mv + shift_off + col); }
#pragma unroll
                for (int ai = 0; ai < 2; ++ai)
#pragma unroll
                    for (int m = 0; m < 4; ++m) { const int r = ai * HALF + wr * 64 + m * 16 + fr; const float rs = Sr[r];
                        const f32x4 v = ai == 0 ? *(const PG8_LAS f32x4*)(T + lbase + m * 16 * LROW + bj * HALF + n * 16) : acc[1][bj][m][n];
                        if (FINAL) *(f32x4*)(o + (size_t)r * 1024 + col) = v * rs * gg;
                        else { const f32x4 h = v * rs * gg * sc + sh; u32x2 w; w.x = cvtpk(h[0], h[1]); w.y = cvtpk(h[2], h[3]); *(u32x2*)(XN + (size_t)(rt + r) * 1024 + col) = w; } } }
    }
};
template <class Epi, class Sched, bool ALIGN_EPI = false, bool SP2 = false>
__device__ __forceinline__ void gemm_phase(PG8_LAS unsigned char* lds, const Gemm g, const Sched& S, const Epi& E) {
    const int tid = threadIdx.x, wid = __builtin_amdgcn_readfirstlane(tid >> 6), lane = tid & 63, wr = wid >> 2, wc = wid & 3, fr = lane & 15, fq = lane >> 4;
    const int K = g.K, nt = K / BK;
    unsigned voffA[2], voffB[2];
#pragma unroll
    for (int i = 0; i < 2; ++i) { int R, C; stage_rc(tid * 16 + i * 8192, R, C); const int Rb = Epi::PERM ? ((R & ~31) + perm32(R & 31)) : R;
        voffA[i] = (unsigned)(R * K + C) * 2u; voffB[i] = (unsigned)(Rb * K + C) * 2u; }
    const size_t kstep = (size_t)(BK * 2);
    const size_t hstep = (size_t)HALF * K * 2;
    const size_t tstep = 2 * hstep;
    const unsigned ldsw = (unsigned)wid * 1024u;
    const int aoff = lds_byte(wr * 64 + fr, fq * 8), boff = lds_byte(wc * 32 + fr, fq * 8);
#define PG8_SA(b, h) (((b) * 2 + (h)) * HTB)
#define PG8_SB(b, h) ((4 + (b) * 2 + (h)) * HTB)
#define PG8_STAGE(bufoff, gbase, voff) do { _Pragma("unroll") for (int _i = 0; _i < 2; ++_i) \
        __builtin_amdgcn_global_load_lds((const unsigned*)((const char*)(gbase) + (voff)[_i]), (PG8_LAS unsigned*)(lds + (bufoff) + ldsw + _i * 8192), 16, 0, 0); } while (0)
#define PG8_LDA(dst, b, h) do { _Pragma("unroll") for (int m = 0; m < 4; ++m) _Pragma("unroll") for (int k = 0; k < 2; ++k) dst[m][k] = *(const PG8_LAS bf16x8*)(lds + PG8_SA(b, h) + aoff + m * 2048 + k * 1024); } while (0)
#define PG8_LDB(dst, b, h) do { _Pragma("unroll") for (int n = 0; n < 2; ++n) _Pragma("unroll") for (int k = 0; k < 2; ++k) dst[n][k] = *(const PG8_LAS bf16x8*)(lds + PG8_SB(b, h) + boff + n * 2048 + k * 1024); } while (0)
#define PG8_MMA(ai, bj, At, Bt) do { __builtin_amdgcn_s_setprio(1); _Pragma("unroll") for (int m = 0; m < 4; ++m) _Pragma("unroll") for (int n = 0; n < 2; ++n) _Pragma("unroll") for (int k = 0; k < 2; ++k) \
        acc[ai][bj][m][n] = __builtin_amdgcn_mfma_f32_16x16x32_bf16(Bt[n][k], At[m][k], acc[ai][bj][m][n], 0, 0, 0); __builtin_amdgcn_s_setprio(0); } while (0)
#define PG8_WAIT_V(n) asm volatile("s_waitcnt vmcnt(" #n ")" ::: "memory")
#define PG8_WAIT_L(n) asm volatile("s_waitcnt lgkmcnt(" #n ")" ::: "memory")
#define PG8_BAR __builtin_amdgcn_s_barrier()
#define PG8_SCHED __builtin_amdgcn_sched_barrier(0)
    Unit cur, nxt; int ui = 0;
    if (!S.next(0, cur)) return;
    f32x4 acc[2][2][4][2];
#pragma unroll
    for (int a = 0; a < 2; ++a)
#pragma unroll
        for (int b = 0; b < 2; ++b)
#pragma unroll
            for (int m = 0; m < 4; ++m)
#pragma unroll
                for (int n = 0; n < 2; ++n) acc[a][b][m][n] = (f32x4){0.f, 0.f, 0.f, 0.f};
    bf16x8 At[4][2], B0[2][2], B1[2][2];
    const char* cA = (const char*)g.A + (size_t)cur.pm * tstep; const char* cB = (const char*)g.Bt + (size_t)cur.pn * tstep;
    S.a_ready(cur);
    if constexpr (SP2) {
        PG8_STAGE(PG8_SB(0, 0), cB, voffB); PG8_STAGE(PG8_SB(0, 1), cB + hstep, voffB); PG8_STAGE(PG8_SA(0, 0), cA, voffA); PG8_STAGE(PG8_SA(0, 1), cA + hstep, voffA);
        if (wr == 1) PG8_BAR;
        PG8_WAIT_V(2); PG8_BAR;
        PG8_STAGE(PG8_SB(1, 0), cB + kstep, voffB); PG8_STAGE(PG8_SA(1, 0), cA + kstep, voffA); PG8_STAGE(PG8_SB(1, 1), cB + hstep + kstep, voffB);
        PG8_WAIT_V(6); PG8_BAR;
    } else {
        PG8_STAGE(PG8_SB(0, 0), cB, voffB); PG8_STAGE(PG8_SA(0, 0), cA, voffA); PG8_STAGE(PG8_SB(0, 1), cB + hstep, voffB); PG8_STAGE(PG8_SA(0, 1), cA + hstep, voffA);
        if (wr == 1) PG8_BAR;
        PG8_WAIT_V(4); PG8_BAR;
        PG8_STAGE(PG8_SB(1, 0), cB + kstep, voffB); PG8_STAGE(PG8_SA(1, 0), cA + kstep, voffA); PG8_STAGE(PG8_SB(1, 1), cB + hstep + kstep, voffB);
        PG8_WAIT_V(6); PG8_BAR;
    }
    for (;;) {
        const bool has_next = S.next(ui + 1, nxt);
        const char* nA = has_next ? (const char*)g.A + (size_t)nxt.pm * tstep : cA; const char* nB = has_next ? (const char*)g.Bt + (size_t)nxt.pn * tstep : cB;
        for (int t = 0; t < nt; t += 2) {
            const bool last = (t == nt - 2);
            const char* a1 = cA + (size_t)(t + 1) * kstep;
            const char* a2 = last ? nA : cA + (size_t)(t + 2) * kstep; const char* b2 = last ? nB : cB + (size_t)(t + 2) * kstep;
            const char* a3 = a2 + kstep; const char* b3 = b2 + kstep;
            if (last && has_next) S.a_ready(nxt);
            if constexpr (SP2) {
            PG8_LDB(B0, 0, 0); PG8_LDB(B1, 0, 1); PG8_SCHED; PG8_LDA(At, 0, 0); PG8_STAGE(PG8_SA(1, 1), a1 + hstep, voffA);
            PG8_WAIT_V(8); PG8_WAIT_L(0); PG8_BAR; PG8_MMA(0, 0, At, B0); PG8_MMA(0, 1, At, B1); PG8_BAR; PG8_SCHED;
            PG8_LDA(At, 0, 1); PG8_STAGE(PG8_SB(0, 0), b2, voffB); PG8_STAGE(PG8_SB(0, 1), b2 + hstep, voffB); PG8_STAGE(PG8_SA(0, 0), a2, voffA);
            PG8_WAIT_V(8); PG8_WAIT_L(0); PG8_BAR; PG8_MMA(1, 0, At, B0); PG8_MMA(1, 1, At, B1); PG8_BAR; PG8_SCHED;
            PG8_LDB(B0, 1, 0); PG8_LDB(B1, 1, 1); PG8_SCHED; PG8_LDA(At, 1, 0); PG8_STAGE(PG8_SA(0, 1), a2 + hstep, voffA);
            PG8_WAIT_V(8); PG8_WAIT_L(0); PG8_BAR; PG8_MMA(0, 0, At, B0); PG8_MMA(0, 1, At, B1); PG8_BAR; PG8_SCHED;
            PG8_LDA(At, 1, 1); PG8_STAGE(PG8_SB(1, 0), b3, voffB); PG8_STAGE(PG8_SB(1, 1), b3 + hstep, voffB); PG8_STAGE(PG8_SA(1, 0), a3, voffA);
            PG8_WAIT_V(8); PG8_WAIT_L(0); PG8_BAR; PG8_MMA(1, 0, At, B0); PG8_MMA(1, 1, At, B1); PG8_BAR; PG8_SCHED;
            } else {
            PG8_LDB(B0, 0, 0); PG8_SCHED; PG8_LDA(At, 0, 0); PG8_STAGE(PG8_SA(1, 1), a1 + hstep, voffA);
            PG8_WAIT_L(8); PG8_BAR; PG8_WAIT_L(0); PG8_MMA(0, 0, At, B0); PG8_BAR; PG8_SCHED;
            PG8_LDB(B1, 0, 1); PG8_STAGE(PG8_SB(0, 0), b2, voffB);
            PG8_BAR; PG8_WAIT_L(0); PG8_MMA(0, 1, At, B1); PG8_BAR;
            PG8_LDA(At, 0, 1); PG8_STAGE(PG8_SA(0, 0), a2, voffA);
            PG8_BAR; PG8_WAIT_L(0); PG8_MMA(1, 0, At, B0); PG8_BAR; PG8_SCHED;
            PG8_STAGE(PG8_SB(0, 1), b2 + hstep, voffB);
            PG8_WAIT_V(6); PG8_BAR; PG8_MMA(1, 1, At, B1); PG8_BAR;
            PG8_LDB(B0, 1, 0); PG8_SCHED; PG8_LDA(At, 1, 0); PG8_STAGE(PG8_SA(0, 1), a2 + hstep, voffA);
            PG8_WAIT_L(8); PG8_BAR; PG8_WAIT_L(0); PG8_MMA(0, 0, At, B0); PG8_BAR; PG8_SCHED;
            PG8_LDB(B1, 1, 1); PG8_STAGE(PG8_SB(1, 0), b3, voffB);
            PG8_BAR; PG8_WAIT_L(0); PG8_MMA(0, 1, At, B1); PG8_BAR;
            PG8_LDA(At, 1, 1); PG8_STAGE(PG8_SA(1, 0), a3, voffA);
            PG8_BAR; PG8_WAIT_L(0); PG8_MMA(1, 0, At, B0); PG8_BAR; PG8_SCHED;
            PG8_STAGE(PG8_SB(1, 1), b3 + hstep, voffB);
            PG8_WAIT_V(6); PG8_BAR; PG8_MMA(1, 1, At, B1); PG8_BAR;
            }
        }
        if constexpr (ALIGN_EPI) { if (wr == 0) PG8_BAR; }
        if constexpr (!Epi::AFTER_DRAIN) { E(acc, cur, wr, wc, fr, fq); S.done(cur); }
        if (!has_next) break;
#pragma unroll
        for (int a = 0; a < 2; ++a)
#pragma unroll
            for (int b = 0; b < 2; ++b)
#pragma unroll
                for (int m = 0; m < 4; ++m)
#pragma unroll
                    for (int n = 0; n < 2; ++n) acc[a][b][m][n] = (f32x4){0.f, 0.f, 0.f, 0.f};
        cur = nxt; cA = nA; cB = nB; ++ui;
        if constexpr (ALIGN_EPI) { if (wr == 1) PG8_BAR; }
    }
    PG8_WAIT_V(0);
    if constexpr (!ALIGN_EPI) { if (wr == 0) PG8_BAR; }
    PG8_BAR;
    if constexpr (Epi::AFTER_DRAIN) { E.fused(acc, cur, wr, wc, fr, fq, lds, wid, lane); S.done(cur); }
#undef PG8_SA
#undef PG8_SB
#undef PG8_STAGE
#undef PG8_LDA
#undef PG8_LDB
#undef PG8_MMA
#undef PG8_WAIT_V
#undef PG8_WAIT_L
#undef PG8_BAR
#undef PG8_SCHED
}
}
#define LAS __attribute__((address_space(3)))
typedef unsigned short bf16_t;
typedef float f32x4 __attribute__((ext_vector_type(4)));
typedef unsigned u32x4 __attribute__((ext_vector_type(4)));
typedef unsigned u32x2 __attribute__((ext_vector_type(2)));
typedef short bf16x8 __attribute__((ext_vector_type(8)));
typedef short s16x4 __attribute__((ext_vector_type(4)));
using pg8::f32x2_t; using pg8::cvtpk; using pg8::fast_exp; using pg8::fast_log; using pg8::fast_rcp; using pg8::silu_f;

constexpr int D = 1024, MTOK = 16384, MP = 8192, NP = 4608, FF = 2816, FF2 = 5632, INW = 4128, NMOD = 6144;
constexpr float EPS = 1e-6f;
constexpr size_t MiB = 1u << 20;
constexpr size_t WS_MOD = 0, WS_C0 = 256 * 1024, WS_C1 = 512 * 1024, WS_PART = 1 * MiB, WS_WIN = 2 * MiB, WS_WO = 11 * MiB, WS_WUP = 13 * MiB, WS_WDN = 24 * MiB,
                 WS_XN = 30 * MiB, WS_P = 62 * MiB, WS_U = 62 * MiB, WS_AFF = 150 * MiB, WS_END = 240 * MiB;
constexpr size_t WS_CNT = 768 * 1024, WS_SLOTS = 239 * MiB;
constexpr size_t WS_BAR = 832 * 1024;
constexpr int LDS_BYTES = 163840, LDS_MISC = 163840 - 64;
constexpr int NPH = 11;

__device__ __forceinline__ float bf_lo(unsigned u) { return __uint_as_float(u << 16); }
__device__ __forceinline__ float bf_hi(unsigned u) { return __uint_as_float(u & 0xffff0000u); }
__device__ __forceinline__ float wave_sum(float v) {
#pragma unroll
    for (int o = 1; o < 64; o <<= 1) v += __shfl_xor(v, o);
    return v;
}

struct Args { const float* in[22]; float* out; unsigned char* ws; int ph_lo, ph_hi; };

__device__ __forceinline__ void tr_store(bf16_t* WT, int K, int dst_row0, int k0, LAS float* scr, int lane) {
    asm volatile("s_waitcnt lgkmcnt(0)" ::: "memory");
    const int c = lane & 7;
#pragma unroll
    for (int j = 0; j < 4; ++j) { const int n = (lane >> 3) + 8 * j; const LAS float* s = scr + (8 * c) * 33 + n;
        u32x4 o; o.x = cvtpk(s[0 * 33], s[1 * 33]); o.y = cvtpk(s[2 * 33], s[3 * 33]); o.z = cvtpk(s[4 * 33], s[5 * 33]); o.w = cvtpk(s[6 * 33], s[7 * 33]);
        *(u32x4*)(WT + (size_t)(dst_row0 + n) * K + k0 + 8 * c) = o; }
    asm volatile("s_waitcnt lgkmcnt(0)" ::: "memory");
}
__device__ __forceinline__ void tr_item(const float* W, int ldw, int src_col0, bf16_t* WT, int K, int dst_row0, int k0, LAS float* scr, int lane) {
#pragma unroll 8
    for (int i = 0; i < 32; ++i) { const int kk = 2 * i + (lane >> 5); scr[kk * 33 + (lane & 31)] = W[(size_t)(k0 + kk) * ldw + src_col0 + (lane & 31)]; }
    tr_store(WT, K, dst_row0, k0, scr, lane);
}
__device__ __forceinline__ void tr_item_alpha(const float* Win, const float* Wup, bf16_t* WT, int nb, int k0, LAS float* scr, int lane) {
    const int n0 = 32 * nb, dir = n0 >> 8, kc = (n0 & 255) + (lane & 31);
    float up[16];
#pragma unroll
    for (int r = 0; r < 16; ++r) up[r] = Wup[(dir * 16 + r) * 256 + kc];
    for (int i = 0; i < 32; ++i) { const int kk = 2 * i + (lane >> 5); const f32x4* wr = (const f32x4*)(Win + (size_t)(k0 + kk) * INW + 1536 + dir * 16);
        float s = 0.f;
#pragma unroll
        for (int q = 0; q < 4; ++q) { const f32x4 w = wr[q]; s += w[0] * up[4 * q] + w[1] * up[4 * q + 1] + w[2] * up[4 * q + 2] + w[3] * up[4 * q + 3]; }
        scr[kk * 33 + (lane & 31)] = s; }
    tr_store(WT, 1024, 4096 + n0, k0, scr, lane);
}

__device__ __forceinline__ void phase_prep(const Args& a, LAS unsigned char* L) {
    const int tid = threadIdx.x, lane = tid & 63, wave = tid >> 6;
    LAS float* scr = (LAS float*)(L + wave * 8704);
    LAS float* sc = (LAS float*)(L + 8 * 8704);
    for (int i = tid; i < 5 * 1024; i += 512) { const int v = i >> 10, k = i & 1023; const float x = v == 0 ? a.in[5][k] : a.in[4][(v - 1) * 1024 + k]; sc[i] = x / (1.f + __expf(-x)); }
    __syncthreads();
    bf16_t* WinT = (bf16_t*)(a.ws + WS_WIN); bf16_t* WoT = (bf16_t*)(a.ws + WS_WO); bf16_t* WupT = (bf16_t*)(a.ws + WS_WUP); bf16_t* WdnT = (bf16_t*)(a.ws + WS_WDN);
    float* part = (float*)(a.ws + WS_PART);
    if (blockIdx.x == 0 && tid < 128) ((unsigned*)(a.ws + WS_CNT))[tid * 64] = 0u;
    const int gw = blockIdx.x * 8 + wave, NGW = gridDim.x * 8;
    constexpr int I_MOD = 96 * 8, I_IN = 16 * 128, I_AL = 16 * 16, I_O = 16 * 32, I_UP = 16 * 176, I_DN = 44 * 32;
    constexpr int NIT = I_MOD + I_IN + I_AL;
    for (int it = gw; it < NIT; it += NGW) {
        int r = it;
        if (r < I_MOD) {
            const int cb = r >> 3, ks = r & 7, col = 64 * cb + lane; const float* w = a.in[6] + (size_t)(128 * ks) * NMOD + col;
            float acc[5] = {0.f, 0.f, 0.f, 0.f, 0.f};
            for (int k = 0; k < 128; k += 16) { float wv[16];
#pragma unroll
                for (int j = 0; j < 16; ++j) wv[j] = w[(size_t)(k + j) * NMOD];
#pragma unroll
                for (int j = 0; j < 16; ++j)
#pragma unroll
                    for (int v = 0; v < 5; ++v) acc[v] += sc[v * 1024 + 128 * ks + k + j] * wv[j]; }
#pragma unroll
            for (int v = 0; v < 5; ++v) part[(size_t)(ks * 5 + v) * NMOD + col] = acc[v];
            continue; }
        r -= I_MOD;
        if (r < I_IN) { const int kb = r >> 7, nb = r & 127, n0 = 32 * nb; tr_item(a.in[10], INW, n0 + (n0 >= 1536 ? 32 : 0), WinT, 1024, n0, 64 * kb, scr, lane); continue; }
        r -= I_IN;
        tr_item_alpha(a.in[10], a.in[11], WinT, r & 15, 64 * (r >> 4), scr, lane);
    }
}
__device__ __forceinline__ void phase_prep_late(const Args& a, LAS unsigned char* L, int nb0) {
    const int tid = threadIdx.x, lane = tid & 63, wave = tid >> 6;
    LAS float* scr = (LAS float*)(L + wave * 8704);
    bf16_t* WoT = (bf16_t*)(a.ws + WS_WO); bf16_t* WupT = (bf16_t*)(a.ws + WS_WUP); bf16_t* WdnT = (bf16_t*)(a.ws + WS_WDN);
    constexpr int I_O = 16 * 32, I_UP = 16 * 176, I_DN = 44 * 32;
    const int gw = ((int)blockIdx.x - nb0) * 8 + wave, NGW = ((int)gridDim.x - nb0) * 8;
    for (int it = gw; it < I_O + I_UP + I_DN; it += NGW) {
        int r = it;
        if (r < I_O) { tr_item(a.in[16], 1024, 32 * (r & 31), WoT, 1024, 32 * (r & 31), 64 * (r >> 5), scr, lane); continue; }
        r -= I_O;
        if (r < I_UP) { const int kb = r / 176, nb = r % 176; tr_item(a.in[17], FF2, 32 * nb, WupT, 1024, 32 * nb, 64 * kb, scr, lane); continue; }
        r -= I_UP;
        { const int kb = r >> 5, nb = r & 31; tr_item(a.in[20], 1024, 32 * nb, WdnT, FF, 32 * nb, 64 * kb, scr, lane); }
    }
}
__device__ __forceinline__ void phase_modfin(const Args& a) {
    const int gt = blockIdx.x * 512 + threadIdx.x, NT = gridDim.x * 512;
    float* mod = (float*)(a.ws + WS_MOD); const float* part = (const float*)(a.ws + WS_PART);
    float* c0 = (float*)(a.ws + WS_C0); float* c1 = (float*)(a.ws + WS_C1);
    for (int i = gt; i < 5 * NMOD; i += NT) { const int v = i / NMOD, col = i % NMOD; float s = a.in[7][col];
#pragma unroll
        for (int ks = 0; ks < 8; ++ks) s += part[(size_t)(ks * 5 + v) * NMOD + col];
        mod[i] = s; }
    for (int i = gt; i < NP; i += NT) { float v0 = 0.f, v1 = 0.f;
        if (i >= 2048 && i < 3072) { const int j = i - 2048; const float a0 = a.in[13][j], a1 = a.in[13][1024 + j]; const float m = fmaxf(a0, a1);
            const float e0 = __expf(a0 - m), e1 = __expf(a1 - m), inv = 1.f / (e0 + e1); v0 = e0 * inv; v1 = e1 * inv; }
        else if (i >= 4096) v0 = a.in[12][i - 4096];
        c0[i] = v0; c1[i] = v1; }
}
__device__ __forceinline__ void phase_norm1(const Args& a, LAS unsigned char* L, bf16_t* XN) {
    phase_modfin(a);
    const int tid = threadIdx.x, lane = tid & 63, wave = tid >> 6;
    const int rbase = blockIdx.x * (MTOK / 256);
    const int mi = rbase < MP ? 0 : 1 + ((rbase - MP) >> 11);
    LAS float* lm = (LAS float*)L;
    const float* part = (const float*)(a.ws + WS_PART);
    __syncthreads();
#pragma unroll
    for (int j = 0; j < 4; ++j) { const int col = tid + 512 * j; float sacc = a.in[7][col];
#pragma unroll
        for (int ks = 0; ks < 8; ++ks) sacc += part[(size_t)(ks * 5 + mi) * NMOD + col];
        lm[col] = sacc; }
    __syncthreads();
    const float* g = a.in[8];
    for (int r = wave; r < MTOK / 256; r += 8) {
        const int row = rbase + r;
        const float* xr = row < MP ? a.in[0] + (size_t)row * D : a.in[1] + (size_t)(row - MP) * D;
        f32x4 v[4]; float sq = 0.f;
#pragma unroll
        for (int j = 0; j < 4; ++j) { v[j] = *(const f32x4*)(xr + 4 * lane + 256 * j); sq += (v[j][0] * v[j][0] + v[j][1] * v[j][1]) + (v[j][2] * v[j][2] + v[j][3] * v[j][3]); }
        const float rstd = rsqrtf(wave_sum(sq) * (1.f / D) + EPS);
#pragma unroll
        for (int j = 0; j < 4; ++j) { const int c = 4 * lane + 256 * j; const f32x4 gg = *(const f32x4*)(g + c), sc = *(const LAS f32x4*)(lm + 1024 + c), sh = *(const LAS f32x4*)(lm + c);
            const f32x4 h = v[j] * rstd * gg * (sc + 1.f) + sh; u32x2 o; o.x = cvtpk(h[0], h[1]); o.y = cvtpk(h[2], h[3]);
            *(u32x2*)(XN + (size_t)row * D + c) = o; }
    }
}
__device__ __forceinline__ void phase_final_norm(float* y, const float* g) {
    const int lane = threadIdx.x & 63, gw = blockIdx.x * 8 + (threadIdx.x >> 6), NGW = gridDim.x * 8;
    for (int row = gw; row < MTOK; row += NGW) {
        float* xr = y + (size_t)row * D; f32x4 v[4]; float s = 0.f;
#pragma unroll
        for (int j = 0; j < 4; ++j) { v[j] = *(const f32x4*)(xr + 4 * lane + 256 * j); s += (v[j][0] * v[j][0] + v[j][1] * v[j][1]) + (v[j][2] * v[j][2] + v[j][3] * v[j][3]); }
        const float rstd = rsqrtf(wave_sum(s) * (1.f / D) + EPS);
#pragma unroll
        for (int j = 0; j < 4; ++j) { const int c = 4 * lane + 256 * j; const f32x4 gg = *(const f32x4*)(g + c); *(f32x4*)(xr + c) = v[j] * rstd * gg; }
    }
}

constexpr size_t WS_SLOC = 206 * MiB, WS_DTOT = 238 * MiB;
static_assert(WS_P + (size_t)MTOK * NP * 2 <= WS_SLOC && WS_DTOT + 256 * 1024 <= 239 * MiB, "ws map");
template <int DK> struct ScanCfg {
    static constexpr int SA = DK == 128 ? 272 : 144, SV = 288;
    static constexpr int OFF_A = 0, OFF_B = 64 * SA, OFF_K = 128 * SA, OFF_V = 192 * SA, OFF_F = OFF_V + 64 * SV, OFF_R = OFF_F + 4 * DK * 4, OFF_L = OFF_R + 64 * 8 * 4, END = OFF_L + 64 * SA;
    static constexpr int OPITCH = 264, OFF_O = END;
    static_assert(OFF_O + 256 * OPITCH <= 163840 - 64, "LDS");
    static constexpr int NPAIR = DK / 2;
    static constexpr int NR = DK / 16, NK = DK / 32;
};
__device__ __forceinline__ s16x4 vtr(const LAS unsigned char* p) { return __builtin_bit_cast(s16x4, __builtin_amdgcn_ds_read_tr16_b64_v4i16((LAS s16x4*)p)); }

template <int DK, bool HG>
__device__ __forceinline__ void scan_load(u32x4 (&R)[HG ? 6 : 5], const bf16_t* P, int row0, int T, int dir, int sc, int qcol, int kcol, int lfcol, int vcol, int tid) {
    const bf16_t* pb = P + (size_t)(row0 + (dir ? T - 1 - 64 * sc : 64 * sc)) * NP;
#pragma unroll
    for (int j = 0; j < (HG ? 6 : 5); ++j) {
        int tl, col;
        if (HG) { const int p = (tid + 512 * j) & 1023; tl = p >> 4; col = (j < 2 ? qcol : (j < 4 ? lfcol : vcol)) + 8 * (p & 15); }
        else if (j < 3) { tl = tid >> 3; col = (j == 0 ? qcol : (j == 1 ? kcol : lfcol)) + 8 * (tid & 7); }
        else { const int p = tid + 512 * (j - 3); tl = p >> 4; col = vcol + 8 * (p & 15); }
        R[j] = *(const u32x4*)(pb + (dir ? -tl : tl) * NP + col);
    }
}
template <int DK, bool HG>
__device__ __forceinline__ void scan_stash(const u32x4 (&R)[HG ? 6 : 5], LAS unsigned char* L, int tid) {
    using C = ScanCfg<DK>;
#pragma unroll
    for (int j = 0; j < (HG ? 6 : 5); ++j) {
        int off;
        if (HG) { const int p = (tid + 512 * j) & 1023; const int tl = p >> 4, ch = p & 15; off = (j < 2 ? C::OFF_A + tl * C::SA : (j < 4 ? C::OFF_L + tl * C::SA : C::OFF_V + tl * C::SV)) + ch * 16; }
        else if (j < 3) { off = (j == 0 ? C::OFF_A : (j == 1 ? C::OFF_B : C::OFF_L)) + (tid >> 3) * C::SA + (tid & 7) * 16; }
        else { const int p = tid + 512 * (j - 3); off = C::OFF_V + (p >> 4) * C::SV + (p & 15) * 16; }
        *(LAS u32x4*)(L + off) = R[j];
    }
}
template <int DK, bool HG, bool LIGHT>
__device__ __forceinline__ void scan_item(LAS unsigned char* L, const bf16_t* P, float* OF, bf16_t* XN, int row0, int T,
                                          int qcol, int kcol, int lfcol_f, int lfcol_b, int vcol, int sgcol, int mcol,
                                          const float* s0f, const float* s0b, const float* cmb_s, const float* cmb_d, int seg, float* sof, float* sob, float* dtot, const float* gnorm) {
    using C = ScanCfg<DK>;
    const int tid = threadIdx.x, lane = tid & 63, wid = tid >> 6, fr = lane & 15, fq = lane >> 4, cb = wid * 16;
    const int nsc = T >> 6;
    const float gn = LIGHT ? 0.f : gnorm[cb + fr];
    for (int dir = 0; dir < 2; ++dir) {
        f32x4 S[C::NR], Dacc[LIGHT ? C::NR : 1];
        { const float* s0 = dir ? s0b : s0f;
#pragma unroll
          for (int r = 0; r < C::NR; ++r) { if (LIGHT) Dacc[r] = (f32x4){1.f, 1.f, 1.f, 1.f};
#pragma unroll
              for (int jj = 0; jj < 4; ++jj) S[r][jj] = s0 ? s0[(16 * r + fq * 4 + jj) * 128 + cb + fr] : 0.f; }
          if (cmb_s) {
              const int n = dir ? 7 - seg : seg;
              for (int q = 0; q < n; ++q) { const int sj = dir ? 7 - q : q;
                  const float* sl = cmb_s + (size_t)(sj * 2 + dir) * 16384; const float* dl = cmb_d + (size_t)(sj * 2 + dir) * 128;
#pragma unroll
                  for (int r = 0; r < C::NR; ++r) { const f32x4 dd = *(const f32x4*)(dl + 16 * r + fq * 4);
#pragma unroll
                      for (int jj = 0; jj < 4; ++jj) S[r][jj] = S[r][jj] * dd[jj] + sl[(16 * r + fq * 4 + jj) * 128 + cb + fr]; } } } }
        const int lfcol = dir ? lfcol_b : lfcol_f;
        u32x4 R[HG ? 6 : 5];
        scan_load<DK, HG>(R, P, row0, T, dir, 0, qcol, kcol, lfcol, vcol, tid);
#pragma unroll 1
        for (int sc = 0; sc < nsc; ++sc) {
            int tid_o = tid; asm volatile("" : "+v"(tid_o));
            const int fr_o = tid_o & 15, fq_o = (tid_o >> 4) & 3, cb_o = (tid_o >> 6) << 4;
            __syncthreads();
            scan_stash<DK, HG>(R, L, tid_o);
            if (sc + 1 < nsc) scan_load<DK, HG>(R, P, row0, T, dir, sc + 1, qcol, kcol, lfcol, vcol, tid_o);
            unsigned sgv[4][4];
            if (!LIGHT && dir == 1) {
                const bf16_t* gb = P + (size_t)(row0 + T - 1 - 64 * sc - fq_o * 4) * NP + sgcol + cb_o + fr_o;
#pragma unroll
                for (int c = 0; c < 4; ++c)
#pragma unroll
                    for (int jj = 0; jj < 4; ++jj) sgv[c][jj] = gb[-(16 * c + jj) * NP];
            }
            __syncthreads();
            if (tid < 8 * C::NPAIR) {
                const int c = tid / (2 * C::NPAIR), rem = tid % (2 * C::NPAIR), half = rem / C::NPAIR, d0 = 2 * (rem % C::NPAIR);
                unsigned lfv[16];
#pragma unroll
                for (int i = 0; i < 16; ++i) lfv[i] = *(const LAS unsigned*)(L + C::OFF_L + (16 * c + i) * C::SA + d0 * 2);
                float h00 = 0.f, h01 = 0.f, h10 = 0.f, h11 = 0.f;
#pragma unroll
                for (int i = 0; i < 8; ++i) { h00 += bf_lo(lfv[i]); h01 += bf_hi(lfv[i]); h10 += bf_lo(lfv[8 + i]); h11 += bf_hi(lfv[8 + i]); }
                const float bl0 = fmaxf(h00 + h10, -80.f), bl1 = fmaxf(h01 + h11, -80.f);
                const float f0 = fast_exp(bl0), f1 = fast_exp(bl1);
                if (half == 0) *(LAS f32x2_t*)(L + C::OFF_F + (c * DK + d0) * 4) = (f32x2_t){f0, f1};
                const unsigned hmask = 0u - (unsigned)half;
                float s0 = half ? h00 : 0.f, s1 = half ? h01 : 0.f;
#pragma unroll
                for (int i = 0; i < 8; ++i) {
                    const unsigned lu = lfv[i] ^ ((lfv[i] ^ lfv[8 + i]) & hmask);
                    s0 += bf_lo(lu); s1 += bf_hi(lu);
                    const float b0 = fmaxf(s0, -80.f), b1 = fmaxf(s1, -80.f);
                    const int o = (16 * c + 8 * half + i) * C::SA + d0 * 2;
                    float k0, k1;
                    if (HG) { k0 = 1.f - fast_exp(bf_lo(lu)); k1 = 1.f - fast_exp(bf_hi(lu)); }
                    else { const unsigned ku = *(const LAS unsigned*)(L + C::OFF_B + o); k0 = bf_lo(ku); k1 = bf_hi(ku); }
                    const float bq0 = k0 * fast_exp(-b0), bq1 = k1 * fast_exp(-b1);
                    if (!LIGHT) {
                        const unsigned qu = *(const LAS unsigned*)(L + C::OFF_A + o);
                        *(LAS unsigned*)(L + C::OFF_A + o) = cvtpk(bf_lo(qu) * fast_exp(b0), bf_hi(qu) * fast_exp(b1));
                        *(LAS unsigned*)(L + C::OFF_B + o) = cvtpk(bq0, bq1);
                    }
                    *(LAS unsigned*)(L + C::OFF_K + o) = cvtpk(bq0 * f0, bq1 * f1);
                }
            }
            __syncthreads();
            f32x4 obuf[4];
            LAS unsigned short* ol = (LAS unsigned short*)(L + C::OFF_O) + (dir ? 255 - 64 * sc - fq * 4 : 64 * sc + fq * 4) * (C::OPITCH / 2) + cb + fr;
#pragma unroll
            for (int c = 0; c < 4; ++c) {
                const s16x4 vb = vtr(L + C::OFF_V + (16 * c + fq * 4 + (fr >> 2)) * C::SV + (cb + 4 * (fr & 3)) * 2);
                f32x4 o = {0.f, 0.f, 0.f, 0.f};
                if (!LIGHT) {
                bf16x8 a1[C::NK], b1[C::NK];
                const LAS unsigned char* pa = L + C::OFF_A + (16 * c + fr) * C::SA + fq * 8;
                const LAS unsigned char* pb = L + C::OFF_B + (16 * c + fr) * C::SA + fq * 8;
#pragma unroll
                for (int kk = 0; kk < C::NK; ++kk) {
                    const s16x4 al = *(const LAS s16x4*)(pa + kk * 64), ah = *(const LAS s16x4*)(pa + kk * 64 + 32);
                    const s16x4 bl = *(const LAS s16x4*)(pb + kk * 64), bh = *(const LAS s16x4*)(pb + kk * 64 + 32);
                    a1[kk] = (bf16x8){al[0], al[1], al[2], al[3], ah[0], ah[1], ah[2], ah[3]};
                    b1[kk] = (bf16x8){bl[0], bl[1], bl[2], bl[3], bh[0], bh[1], bh[2], bh[3]};
                }
                f32x4 sT = {0.f, 0.f, 0.f, 0.f};
#pragma unroll
                for (int kk = 0; kk < C::NK; ++kk) sT = __builtin_amdgcn_mfma_f32_16x16x32_bf16(b1[kk], a1[kk], sT, 0, 0, 0);
#pragma unroll
                for (int jj = 0; jj < 4; ++jj) sT[jj] = (fq * 4 + jj <= fr) ? sT[jj] : 0.f;
                const unsigned p01 = cvtpk(sT[0], sT[1]), p23 = cvtpk(sT[2], sT[3]);
                const s16x4 pfrag = __builtin_bit_cast(s16x4, (u32x2){p01, p23});
                o = __builtin_amdgcn_mfma_f32_16x16x16bf16_1k(pfrag, vb, (f32x4){0.f, 0.f, 0.f, 0.f}, 0, 0, 0);
#pragma unroll
                for (int kk = 0; kk < C::NK; ++kk) {
                    const u32x4 sw = {cvtpk(S[2 * kk][0], S[2 * kk][1]), cvtpk(S[2 * kk][2], S[2 * kk][3]), cvtpk(S[2 * kk + 1][0], S[2 * kk + 1][1]), cvtpk(S[2 * kk + 1][2], S[2 * kk + 1][3])};
                    o = __builtin_amdgcn_mfma_f32_16x16x32_bf16(a1[kk], __builtin_bit_cast(bf16x8, sw), o, 0, 0, 0);
                }
                }
#pragma unroll
                for (int r = 0; r < C::NR; ++r) {
                    const f32x4 fc = *(const LAS f32x4*)(L + C::OFF_F + (c * DK + 16 * r + fq * 4) * 4);
                    const s16x4 ka = vtr(L + C::OFF_K + (16 * c + fq * 4 + (fr >> 2)) * C::SA + (16 * r + 4 * (fr & 3)) * 2);
                    S[r] = __builtin_amdgcn_mfma_f32_16x16x16bf16_1k(ka, vb, S[r] * fc, 0, 0, 0);
                    if (LIGHT) Dacc[r] = Dacc[r] * fc;
                }
#pragma unroll
                for (int jj = 0; jj < 4; ++jj) { if (LIGHT) continue;
                    if (dir == 0) ol[(16 * c + jj) * (C::OPITCH / 2)] = (unsigned short)(cvtpk(o[jj], o[jj]) & 0xffffu); else o[jj] += __uint_as_float((unsigned)ol[-(16 * c + jj) * (C::OPITCH / 2)] << 16); }
                obuf[c] = o;
            }
            if (!LIGHT && dir == 1) {
#pragma unroll
                for (int c = 0; c < 4; ++c)
#pragma unroll
                    for (int jj = 0; jj < 4; ++jj) { float ss = obuf[c][jj] * obuf[c][jj]; ss += __shfl_xor(ss, 1); ss += __shfl_xor(ss, 2); ss += __shfl_xor(ss, 4); ss += __shfl_xor(ss, 8);
                        if (fr == 0) *(LAS float*)(L + C::OFF_R + ((16 * c + fq * 4 + jj) * 8 + wid) * 4) = ss; }
                __syncthreads();
                bf16_t* xo = XN + (size_t)(row0 + T - 1 - 64 * sc - fq_o * 4) * D + mcol + cb_o + fr_o;
#pragma unroll
                for (int c = 0; c < 4; ++c)
#pragma unroll
                    for (int jj = 0; jj < 4; ++jj) { const int tl = 16 * c + fq * 4 + jj; const f32x4 r0 = *(const LAS f32x4*)(L + C::OFF_R + tl * 32), r1 = *(const LAS f32x4*)(L + C::OFF_R + tl * 32 + 16);
                        const float tot = ((r0[0] + r0[1]) + (r0[2] + r0[3])) + ((r1[0] + r1[1]) + (r1[2] + r1[3]));
                        const float rstd = rsqrtf(tot * (1.f / 128.f) + EPS);
                        const float sg = __uint_as_float(sgv[c][jj] << 16);
                        const float val = obuf[c][jj] * rstd * gn * sg;
                        xo[-(16 * c + jj) * D] = (bf16_t)(cvtpk(val, val) & 0xffffu); }
            }
        }
        float* so = dir ? sob : sof;
        if (so) {
#pragma unroll
            for (int r = 0; r < C::NR; ++r)
#pragma unroll
                for (int jj = 0; jj < 4; ++jj) so[(16 * r + fq * 4 + jj) * 128 + cb + fr] = S[r][jj]; }
        if (LIGHT && wid == 0 && fr == 0) {
#pragma unroll
            for (int r = 0; r < C::NR; ++r) *(f32x4*)(dtot + dir * 128 + 16 * r + fq * 4) = Dacc[r]; }
    }
}

template <int DK, bool HG>
__device__ __forceinline__ void scan_light2(LAS unsigned char* L, const bf16_t* P, int row0, int kcol, int lfcol_f, int lfcol_b, int vcol, float* so_f, float* so_b, float* dtot) {
    constexpr int SA = DK * 2 + 32, SV = 288, NR = DK / 16, NPAIR = DK / 2;
    constexpr int OFF_L = 0, OFF_K = 128 * SA, OFF_V = 256 * SA, OFF_G = OFF_V + 128 * SV, OFF_F = OFF_G + 8 * DK * 4, OFF_T = OFF_F + DK * 4;
    static_assert(OFF_T + DK * 4 <= 147392, "LDS");
    const int tid0 = threadIdx.x;
#pragma unroll 1
    for (int dir = 0; dir < 2; ++dir) {
        const int lfcol = dir ? lfcol_b : lfcol_f;
        f32x4 S[NR];
#pragma unroll
        for (int r = 0; r < NR; ++r) S[r] = (f32x4){0.f, 0.f, 0.f, 0.f};
        u32x4 R[8];
#pragma unroll 1
        for (int st = 0; st < 2; ++st) {
            int tid = tid0; asm volatile("" : "+v"(tid));
            const int lane = tid & 63, wid = tid >> 6, fr = lane & 15, fq = lane >> 4, cb = wid * 16;
            {
                const bf16_t* pb = P + (size_t)(row0 + (dir ? 255 - 128 * st : 128 * st)) * NP;
#pragma unroll
                for (int j = 0; j < 8; ++j) {
                    int tl, col;
                    if (j >= 4) { const int p = tid + 512 * (j - 4); tl = p >> 4; col = vcol + 8 * (p & 15); }
                    else if (HG) { const int p = tid + 512 * j; tl = p >> 4; col = lfcol + 8 * (p & 15); }
                    else { const int p = tid + 512 * (j & 1); tl = p >> 3; col = (j < 2 ? lfcol : kcol) + 8 * (p & 7); }
                    R[j] = *(const u32x4*)(pb + (dir ? -tl : tl) * NP + col);
                }
            }
            __syncthreads();
#pragma unroll
            for (int j = 0; j < 8; ++j) {
                int off;
                if (j >= 4) { const int p = tid + 512 * (j - 4); off = OFF_V + (p >> 4) * SV + (p & 15) * 16; }
                else if (HG) { const int p = tid + 512 * j; off = OFF_L + (p >> 4) * SA + (p & 15) * 16; }
                else { const int p = tid + 512 * (j & 1); off = (j < 2 ? OFF_L : OFF_K) + (p >> 3) * SA + (p & 7) * 16; }
                *(LAS u32x4*)(L + off) = R[j];
            }
            __syncthreads();
            const bool act = tid < 8 * NPAIR;
            const int g = tid / NPAIR, d0 = 2 * (tid % NPAIR);
            unsigned lfv[16]; float s0 = 0.f, s1 = 0.f;
            if (act) {
#pragma unroll
                for (int i = 0; i < 16; ++i) { lfv[i] = *(const LAS unsigned*)(L + OFF_L + (16 * g + i) * SA + d0 * 2); s0 += bf_lo(lfv[i]); s1 += bf_hi(lfv[i]); }
                *(LAS f32x2_t*)(L + OFF_G + (g * DK + d0) * 4) = (f32x2_t){s0, s1};
            }
            __syncthreads();
            if (act) {
                float a0 = 0.f, a1 = 0.f;
#pragma unroll
                for (int gp = 1; gp < 8; ++gp) { const f32x2_t t = *(const LAS f32x2_t*)(L + OFF_G + (gp * DK + d0) * 4); if (gp > g) { a0 += t.x; a1 += t.y; } }
                if (g == 0) { const float t0 = s0 + a0, t1 = s1 + a1;
                    *(LAS f32x2_t*)(L + OFF_F + d0 * 4) = (f32x2_t){fast_exp(fmaxf(t0, -80.f)), fast_exp(fmaxf(t1, -80.f))};
                    LAS f32x2_t* tp = (LAS f32x2_t*)(L + OFF_T + d0 * 4); if (st == 0) *tp = (f32x2_t){t0, t1}; else { const f32x2_t o = *tp; *tp = (f32x2_t){o.x + t0, o.y + t1}; } }
#pragma unroll
                for (int i = 15; i >= 0; --i) {
                    const int o = (16 * g + i) * SA + d0 * 2;
                    float k0, k1;
                    if (HG) { k0 = 1.f - fast_exp(bf_lo(lfv[i])); k1 = 1.f - fast_exp(bf_hi(lfv[i])); }
                    else { const unsigned ku = *(const LAS unsigned*)(L + OFF_K + o); k0 = bf_lo(ku); k1 = bf_hi(ku); }
                    *(LAS unsigned*)(L + OFF_K + o) = cvtpk(k0 * fast_exp(fmaxf(a0, -80.f)), k1 * fast_exp(fmaxf(a1, -80.f)));
                    a0 += bf_lo(lfv[i]); a1 += bf_hi(lfv[i]);
                }
            }
            __syncthreads();
#pragma unroll
            for (int r = 0; r < NR; ++r) { const f32x4 fd = *(const LAS f32x4*)(L + OFF_F + (16 * r + fq * 4) * 4); S[r] = S[r] * fd; }
#pragma unroll
            for (int ks = 0; ks < 4; ++ks) {
                const int rb = 32 * ks + fq * 8 + (fr >> 2);
                const s16x4 vl = vtr(L + OFF_V + rb * SV + (cb + 4 * (fr & 3)) * 2), vh = vtr(L + OFF_V + (rb + 4) * SV + (cb + 4 * (fr & 3)) * 2);
                const bf16x8 vb = (bf16x8){vl[0], vl[1], vl[2], vl[3], vh[0], vh[1], vh[2], vh[3]};
#pragma unroll
                for (int r = 0; r < NR; ++r) {
                    const s16x4 kl = vtr(L + OFF_K + rb * SA + (16 * r + 4 * (fr & 3)) * 2), kh = vtr(L + OFF_K + (rb + 4) * SA + (16 * r + 4 * (fr & 3)) * 2);
                    const bf16x8 ka = (bf16x8){kl[0], kl[1], kl[2], kl[3], kh[0], kh[1], kh[2], kh[3]};
                    S[r] = __builtin_amdgcn_mfma_f32_16x16x32_bf16(ka, vb, S[r], 0, 0, 0);
                }
            }
            if (st == 1) {
                float* so = dir ? so_b : so_f;
#pragma unroll
                for (int r = 0; r < NR; ++r)
#pragma unroll
                    for (int jj = 0; jj < 4; ++jj) so[(16 * r + fq * 4 + jj) * 128 + cb + fr] = S[r][jj];
                if (tid < DK) dtot[dir * 128 + tid] = fast_exp(fmaxf(*(const LAS float*)(L + OFF_T + tid * 4), -80.f));
            }
        }
    }
}

__device__ __forceinline__ void phase_scan_light(const Args& a, LAS unsigned char* L) {
    const bf16_t* P = (const bf16_t*)(a.ws + WS_P);
    for (int j = blockIdx.x; j < 256; j += gridDim.x) {
        const int b = j >> 6, hh = (j >> 3) & 7, seg = j & 7, h = hh & 3, row0 = MP + b * 2048 + seg * 256;
        float* sl = (float*)(a.ws + WS_SLOC) + (size_t)j * 2 * 16384; float* dt = (float*)(a.ws + WS_DTOT) + (size_t)j * 2 * 128;
        if (hh < 4) scan_light2<64, false>(L, P, row0, 256 + h * 64, 4096 + h * 64, 4352 + h * 64, 512 + h * 128, sl, sl + 16384, dt);
        else scan_light2<128, true>(L, P, row0, 0, 2048 + h * 128, 2560 + h * 128, 3072 + h * 128, sl, sl + 16384, dt);
    }
}
__device__ __forceinline__ void phase_scan(const Args& a, LAS unsigned char* L) {
    const bf16_t* P = (const bf16_t*)(a.ws + WS_P); bf16_t* XN = (bf16_t*)(a.ws + WS_XN); float* OF = a.out;
    float* og = a.out + (size_t)MTOK * D; float* oh = og + 32 * 2 * 4 * 64 * 128;
    for (int j = blockIdx.x; j < 512; j += gridDim.x) {
        const bool samp = j >= 256; int b, hh, seg = 0, row0;
        if (samp) { const int q = j - 256;
            b = q >> 6; hh = ((((q >> 2) & 1) ^ 1) << 2) | ((q >> 3) & 3); seg = (((q >> 5) & 1) << 2) | (q & 3); row0 = MP + b * 2048 + seg * 256; } else { b = j >> 3; hh = j & 7; row0 = b * 256; }
        const int h = hh & 3;
        const int li0 = (b * 8 + hh) * 8;
        const float* cs = samp ? (const float*)(a.ws + WS_SLOC) + (size_t)li0 * 2 * 16384 : nullptr;
        const float* cd = samp ? (const float*)(a.ws + WS_DTOT) + (size_t)li0 * 2 * 128 : nullptr;
        if (hh < 4) {
            const size_t so = (size_t)(b * 2 * 4 + h) * 64 * 128, sd = (size_t)4 * 64 * 128;
            scan_item<64, false, false>(L, P, OF, XN, row0, 256, h * 64, 256 + h * 64, 4096 + h * 64, 4352 + h * 64, 512 + h * 128, 1024 + h * 128, h * 128,
                                       samp ? a.in[2] + so : nullptr, samp ? a.in[2] + so + sd : nullptr, cs, cd, seg, samp ? nullptr : og + so, samp ? nullptr : og + so + sd, nullptr, a.in[14]);
        } else {
            const size_t so = (size_t)(b * 2 * 4 + h) * 128 * 128, sd = (size_t)4 * 128 * 128;
            scan_item<128, true, false>(L, P, OF, XN, row0, 256, 1536 + h * 128, 0, 2048 + h * 128, 2560 + h * 128, 3072 + h * 128, 3584 + h * 128, 512 + h * 128,
                                       samp ? a.in[3] + so : nullptr, samp ? a.in[3] + so + sd : nullptr, cs, cd, seg, samp ? nullptr : oh + so, samp ? nullptr : oh + so + sd, nullptr, a.in[15]);
        }
    }
}

#define OPAQUE(p) asm volatile("" : "+v"(p))
template <bool GRID>
__device__ __forceinline__ void conv_load(u32x4 (&R)[GRID ? 13 : 5], u32x4 (&W)[2], const bf16_t* U, const float* cw, const float* cbias, int it, int tid) {
    constexpr int NR = GRID ? 3 : 1, NT = GRID ? 9 : 3, NPJ = GRID ? 13 : 5, TOT = NR * 66 * 32;
    const int span = it / 22, cb = it % 22;
    const bf16_t* ub = U + (size_t)span * 64 * FF2 + cb * 128; OPAQUE(ub);
#pragma unroll
    for (int j = 0; j < NPJ; ++j) {
        const int p = tid + 512 * j;
        const int rr = p / (66 * 32), rem = p % (66 * 32), s = rem >> 5, pc = rem & 31;
        bool ok; int roff;
        if (GRID) { const int r = (span & 31) + rr - 1; ok = (p < TOT) & (r >= 0) & (r < 32) & (s >= 1) & (s <= 64); roff = (rr - 1) * 64 + s - 1; }
        else { ok = (p < TOT) & (((s >= 1) & (s <= 64)) | ((s == 0) & ((span & 3) != 0)) | ((s == 65) & ((span & 3) != 3))); roff = s - 1; }
        const int off = ok ? roff * FF2 + (pc < 16 ? pc * 8 : FF + (pc - 16) * 8) : 0;
        u32x4 v = *(const u32x4*)(ub + off);
        const unsigned m = ok ? 0xffffffffu : 0u;
        v.x &= m; v.y &= m; v.z &= m; v.w &= m;
        R[j] = v;
    }
#pragma unroll
    for (int j = 0; j < 2; ++j) {
        const int p = tid + 512 * j;
        const bool isw = p < NT * 64; const int q = isw ? p : (p < NT * 64 + 64 ? p - NT * 64 : 0);
        const int tap = q >> 6, g = (q >> 5) & 1, c4 = q & 31;
        const float* src = isw ? cw + (size_t)(GRID ? tap : 3 + tap) * FF2 : cbias;
        W[j] = *(const u32x4*)(src + g * FF + cb * 128 + c4 * 4);
    }
}
__device__ __forceinline__ void conv_fma(float (&ag)[8], float (&au)[8], const u32x4 gv, const u32x4 uv, const LAS float* wg) {
    const f32x4 wg0 = *(const LAS f32x4*)wg, wg1 = *(const LAS f32x4*)(wg + 4), wu0 = *(const LAS f32x4*)(wg + 128), wu1 = *(const LAS f32x4*)(wg + 132);
    ag[0] += bf_lo(gv[0]) * wg0[0]; ag[1] += bf_hi(gv[0]) * wg0[1]; ag[2] += bf_lo(gv[1]) * wg0[2]; ag[3] += bf_hi(gv[1]) * wg0[3];
    ag[4] += bf_lo(gv[2]) * wg1[0]; ag[5] += bf_hi(gv[2]) * wg1[1]; ag[6] += bf_lo(gv[3]) * wg1[2]; ag[7] += bf_hi(gv[3]) * wg1[3];
    au[0] += bf_lo(uv[0]) * wu0[0]; au[1] += bf_hi(uv[0]) * wu0[1]; au[2] += bf_lo(uv[1]) * wu0[2]; au[3] += bf_hi(uv[1]) * wu0[3];
    au[4] += bf_lo(uv[2]) * wu1[0]; au[5] += bf_hi(uv[2]) * wu1[1]; au[6] += bf_lo(uv[3]) * wu1[2]; au[7] += bf_hi(uv[3]) * wu1[3];
}
template <bool GRID>
__device__ __forceinline__ void phase_conv(const Args& a, LAS unsigned char* L, const bf16_t* U, bf16_t* Aff) {
    constexpr int NR = GRID ? 3 : 1, NT = GRID ? 9 : 3, NPJ = GRID ? 13 : 5, TOT = NR * 66 * 32;
    constexpr int ROWB = 66 * 512, OFF_W = NR * ROWB;
    const float* cw = a.in[18]; const float* cbias = a.in[19];
    const int tid0 = threadIdx.x;
    u32x4 R[NPJ], W[2];
    int it = blockIdx.x;
#pragma unroll 1
    for (; it < 128 * 22; it += gridDim.x) {
        int tid = tid0; asm volatile("" : "+v"(tid));
        const int cgl = tid & 15, tp = tid >> 4;
        conv_load<GRID>(R, W, U, cw, cbias, it, tid);
        __syncthreads();
#pragma unroll
        for (int j = 0; j < NPJ; ++j) { const int p = tid + 512 * j; if (p < TOT) *(LAS u32x4*)(L + p * 16) = R[j]; }
#pragma unroll
        for (int j = 0; j < 2; ++j) { const int p = tid + 512 * j; if (p < NT * 64 + 64) *(LAS u32x4*)(L + OFF_W + p * 16) = W[j]; }
        const int span = it / 22, cb = it % 22;
        __syncthreads();
        float ag[2][8], au[2][8];
        { const LAS float* bl = (const LAS float*)(L + OFF_W + NT * 1024);
          const f32x4 g0 = *(const LAS f32x4*)(bl + cgl * 8), g1 = *(const LAS f32x4*)(bl + cgl * 8 + 4), u0 = *(const LAS f32x4*)(bl + 128 + cgl * 8), u1 = *(const LAS f32x4*)(bl + 128 + cgl * 8 + 4);
#pragma unroll
          for (int t = 0; t < 2; ++t)
#pragma unroll
              for (int e = 0; e < 4; ++e) { ag[t][e] = g0[e]; ag[t][4 + e] = g1[e]; au[t][e] = u0[e]; au[t][4 + e] = u1[e]; } }
#pragma unroll 1
        for (int rr = 0; rr < NR; ++rr) {
#pragma unroll
            for (int cs = 0; cs < 4; ++cs) {
                const LAS unsigned char* tp_ = L + rr * ROWB + (2 * tp + cs) * 512 + cgl * 16;
                const u32x4 gv = *(const LAS u32x4*)tp_, uv = *(const LAS u32x4*)(tp_ + 256);
                if (cs <= 2) conv_fma(ag[0], au[0], gv, uv, (const LAS float*)(L + OFF_W) + (rr * 3 + cs) * 256 + cgl * 8);
                if (cs >= 1) conv_fma(ag[1], au[1], gv, uv, (const LAS float*)(L + OFF_W) + (rr * 3 + cs - 1) * 256 + cgl * 8);
            }
        }
#pragma unroll
        for (int t = 0; t < 2; ++t) {
            u32x4 o;
            o.x = cvtpk(silu_f(ag[t][0]) * au[t][0], silu_f(ag[t][1]) * au[t][1]); o.y = cvtpk(silu_f(ag[t][2]) * au[t][2], silu_f(ag[t][3]) * au[t][3]);
            o.z = cvtpk(silu_f(ag[t][4]) * au[t][4], silu_f(ag[t][5]) * au[t][5]); o.w = cvtpk(silu_f(ag[t][6]) * au[t][6], silu_f(ag[t][7]) * au[t][7]);
            *(u32x4*)(Aff + (size_t)(span * 64 + 2 * tp + t) * FF + cb * 128 + cgl * 8) = o;
        }
    }
}

__device__ __forceinline__ void conv_fma64(float (&ag)[8], float (&au)[8], const float (&g)[8], const float (&u)[8], const LAS float* wg) {
    const f32x4 wg0 = *(const LAS f32x4*)wg, wg1 = *(const LAS f32x4*)(wg + 4), wu0 = *(const LAS f32x4*)(wg + 64), wu1 = *(const LAS f32x4*)(wg + 68);
#pragma unroll
    for (int e = 0; e < 4; ++e) { ag[e] += g[e] * wg0[e]; ag[4 + e] += g[4 + e] * wg1[e]; au[e] += u[e] * wu0[e]; au[4 + e] += u[4 + e] * wu1[e]; }
}
__device__ __forceinline__ void phase_conv_grid4(const Args& a, LAS unsigned char* L, const bf16_t* U, bf16_t* Aff) {
    constexpr int ROWB = 66 * 256, TOT = 6 * 66 * 16, OFF_W = 6 * ROWB, NIT = 32 * 44;
    const float* cw = a.in[18]; const float* cbias = a.in[19];
    const int tid0 = threadIdx.x;
#pragma unroll 1
    for (int it = blockIdx.x; it < NIT; it += gridDim.x) {
        int tid = tid0; asm volatile("" : "+v"(tid));
        const int q4 = it / 44, cb = it % 44, batch = q4 >> 3, r0 = (q4 & 7) * 4;
        u32x4 R[13], W;
        { const bf16_t* ub = U + (size_t)(batch * 2048 + r0 * 64) * FF2 + cb * 64;
#pragma unroll
          for (int j = 0; j < 13; ++j) {
              const int p = tid + 512 * j;
              const int rr = p / 1056, rem = p % 1056, sl = rem >> 4, pc = rem & 15, r = r0 + rr - 1;
              const bool ok = (p < TOT) & (r >= 0) & (r < 32) & (sl >= 1) & (sl <= 64);
              const int off = ok ? ((rr - 1) * 64 + sl - 1) * FF2 + (pc < 8 ? pc * 8 : FF + (pc - 8) * 8) : 0;
              u32x4 v = *(const u32x4*)(ub + (ok ? off : 64 * FF2));
              const unsigned m = ok ? 0xffffffffu : 0u; v.x &= m; v.y &= m; v.z &= m; v.w &= m; R[j] = v; }
          const int p = tid < 320 ? tid : 0; const bool isw = p < 288; const int qq = isw ? p : p - 288;
          const int tap = qq >> 5, g = (qq >> 4) & 1, c4 = qq & 15;
          W = *(const u32x4*)((isw ? cw + (size_t)tap * FF2 : cbias) + g * FF + cb * 64 + c4 * 4); }
        __syncthreads();
#pragma unroll
        for (int j = 0; j < 13; ++j) { const int p = tid + 512 * j; if (p < TOT) *(LAS u32x4*)(L + p * 16) = R[j]; }
        if (tid < 320) *(LAS u32x4*)(L + OFF_W + tid * 16) = W;
        __syncthreads();
        const int cgl = tid & 7, w = tid >> 3;
        float ag[4][8], au[4][8];
        { const LAS float* bl = (const LAS float*)(L + OFF_W + 9 * 512);
          const f32x4 g0 = *(const LAS f32x4*)(bl + cgl * 8), g1 = *(const LAS f32x4*)(bl + cgl * 8 + 4), u0 = *(const LAS f32x4*)(bl + 64 + cgl * 8), u1 = *(const LAS f32x4*)(bl + 64 + cgl * 8 + 4);
#pragma unroll
          for (int t = 0; t < 4; ++t)
#pragma unroll
              for (int e = 0; e < 4; ++e) { ag[t][e] = g0[e]; ag[t][4 + e] = g1[e]; au[t][e] = u0[e]; au[t][4 + e] = u1[e]; } }
#pragma unroll 1
        for (int kw = 0; kw < 3; ++kw) {
#pragma unroll
            for (int rr = 0; rr < 6; ++rr) {
                const LAS unsigned char* tp_ = L + rr * ROWB + (w + kw) * 256 + cgl * 16;
                const u32x4 gv = *(const LAS u32x4*)tp_, uv = *(const LAS u32x4*)(tp_ + 128);
                float g[8], u[8];
#pragma unroll
                for (int e = 0; e < 4; ++e) { g[2 * e] = bf_lo(gv[e]); g[2 * e + 1] = bf_hi(gv[e]); u[2 * e] = bf_lo(uv[e]); u[2 * e + 1] = bf_hi(uv[e]); }
#pragma unroll
                for (int kh = 0; kh < 3; ++kh) { const int ro = rr - kh; if (ro >= 0 && ro <= 3) conv_fma64(ag[ro], au[ro], g, u, (const LAS float*)(L + OFF_W) + (kh * 3 + kw) * 128 + cgl * 8); }
            }
        }
#pragma unroll
        for (int t = 0; t < 4; ++t) {
            u32x4 o;
            o.x = cvtpk(silu_f(ag[t][0]) * au[t][0], silu_f(ag[t][1]) * au[t][1]); o.y = cvtpk(silu_f(ag[t][2]) * au[t][2], silu_f(ag[t][3]) * au[t][3]);
            o.z = cvtpk(silu_f(ag[t][4]) * au[t][4], silu_f(ag[t][5]) * au[t][5]); o.w = cvtpk(silu_f(ag[t][6]) * au[t][6], silu_f(ag[t][7]) * au[t][7]);
            *(u32x4*)(Aff + (size_t)(batch * 2048 + (r0 + t) * 64 + w) * FF + cb * 64 + cgl * 8) = o;
        }
    }
}

__device__ __forceinline__ void conv_seq_load(u32x4 (&R)[8], u32x4& W, const bf16_t* U, const float* cw, const float* cbias, int it, int tid) {
    const int b = it / 44, cb = it % 44;
        { const bf16_t* ub = U + (size_t)b * 256 * FF2 + cb * 64;
#pragma unroll
          for (int j = 0; j < 8; ++j) { const int p = tid + 512 * j, t = p >> 4, pc = p & 15; R[j] = *(const u32x4*)(ub + (size_t)t * FF2 + (pc < 8 ? pc * 8 : FF + (pc - 8) * 8)); }
          const int p = tid < 128 ? tid : 0; const bool isw = p < 96; const int qq = isw ? p : p - 96;
          const int tap = qq >> 5, g = (qq >> 4) & 1, c4 = qq & 15;
          W = *(const u32x4*)((isw ? cw + (size_t)tap * FF2 : cbias) + g * FF + cb * 64 + c4 * 4); }
}
__device__ __forceinline__ void phase_conv_seq(const Args& a, LAS unsigned char* L, const bf16_t* U, bf16_t* Aff) {
    constexpr int OFF_W = 258 * 256, NIT = 32 * 44;
    const float* cw = a.in[18] + 3 * FF2; const float* cbias = a.in[19];
    const int tid0 = threadIdx.x;
    __syncthreads();
    if (tid0 < 32) { const int side = tid0 >> 4, pc = tid0 & 15; *(LAS u32x4*)(L + (side ? 257 : 0) * 256 + pc * 16) = (u32x4){0u, 0u, 0u, 0u}; }
    u32x4 R[8], W;
    if ((int)blockIdx.x < NIT) conv_seq_load(R, W, U, cw, cbias, blockIdx.x, tid0);
#pragma unroll 1
    for (int it = blockIdx.x; it < NIT; it += gridDim.x) {
        int tid = tid0; asm volatile("" : "+v"(tid));
        const int b = it / 44, cb = it % 44;
        __syncthreads();
#pragma unroll
        for (int j = 0; j < 8; ++j) { const int p = tid + 512 * j; *(LAS u32x4*)(L + 256 + p * 16) = R[j]; }
        if (tid < 128) *(LAS u32x4*)(L + OFF_W + tid * 16) = W;
        if (it + (int)gridDim.x < NIT) conv_seq_load(R, W, U, cw, cbias, it + gridDim.x, tid);
        __syncthreads();
        const int cgl = tid & 7, tq = tid >> 3;
        float ag[4][8], au[4][8];
        { const LAS float* bl = (const LAS float*)(L + OFF_W + 3 * 512);
          const f32x4 g0 = *(const LAS f32x4*)(bl + cgl * 8), g1 = *(const LAS f32x4*)(bl + cgl * 8 + 4), u0 = *(const LAS f32x4*)(bl + 64 + cgl * 8), u1 = *(const LAS f32x4*)(bl + 64 + cgl * 8 + 4);
#pragma unroll
          for (int t = 0; t < 4; ++t)
#pragma unroll
              for (int e = 0; e < 4; ++e) { ag[t][e] = g0[e]; ag[t][4 + e] = g1[e]; au[t][e] = u0[e]; au[t][4 + e] = u1[e]; } }
#pragma unroll
        for (int cs = 0; cs < 6; ++cs) {
            const LAS unsigned char* tp_ = L + (4 * tq + cs) * 256 + cgl * 16;
            const u32x4 gv = *(const LAS u32x4*)tp_, uv = *(const LAS u32x4*)(tp_ + 128);
            float g[8], u[8];
#pragma unroll
            for (int e = 0; e < 4; ++e) { g[2 * e] = bf_lo(gv[e]); g[2 * e + 1] = bf_hi(gv[e]); u[2 * e] = bf_lo(uv[e]); u[2 * e + 1] = bf_hi(uv[e]); }
#pragma unroll
            for (int t = 0; t < 4; ++t) { const int kw = cs - t; if (kw >= 0 && kw <= 2) conv_fma64(ag[t], au[t], g, u, (const LAS float*)(L + OFF_W) + kw * 128 + cgl * 8); }
        }
#pragma unroll
        for (int t = 0; t < 4; ++t) {
            u32x4 o;
            o.x = cvtpk(silu_f(ag[t][0]) * au[t][0], silu_f(ag[t][1]) * au[t][1]); o.y = cvtpk(silu_f(ag[t][2]) * au[t][2], silu_f(ag[t][3]) * au[t][3]);
            o.z = cvtpk(silu_f(ag[t][4]) * au[t][4], silu_f(ag[t][5]) * au[t][5]); o.w = cvtpk(silu_f(ag[t][6]) * au[t][6], silu_f(ag[t][7]) * au[t][7]);
            *(u32x4*)(Aff + (size_t)(b * 256 + 4 * tq + t) * FF + cb * 64 + cgl * 8) = o;
        }
    }
}

#define XB_TMO      128
#define XB_XCNT(j)  (256  + 64 * (j))
#define XB_XSUB(j)  (1280 + 64 * (j))
#define XB_XGEN(j)  (2304 + 64 * (j))
#define XB_TOP      3328
#define XB_TOPGEN   3392
#define XCD_BAR_WORDS 3456
#define XB_SPIN_CAP (1u << 18)

__device__ __forceinline__ unsigned xb_ld(unsigned* p)              { return __hip_atomic_load(p, __ATOMIC_RELAXED, __HIP_MEMORY_SCOPE_AGENT); }
__device__ __forceinline__ unsigned xb_add(unsigned* p, unsigned v) { return __hip_atomic_fetch_add(p, v, __ATOMIC_RELAXED, __HIP_MEMORY_SCOPE_AGENT); }
__device__ __forceinline__ unsigned xb_xcc_id() { return (unsigned)__builtin_amdgcn_s_getreg((3 << 11) | 20) & 0xFu; }
#define XB_SPIN(cond, bar) do { unsigned _sp = 0; while (cond) { __builtin_amdgcn_s_sleep(1); \
    if ((++_sp & 255u) == 0u) { if (xb_ld(&(bar)[XB_TMO])) break; if (_sp > XB_SPIN_CAP) { atomicAdd(&(bar)[XB_TMO], 1u); break; } } } } while (0)

struct XcdBarrier {
    unsigned* bar; unsigned x;
    volatile LAS unsigned* st;
};

__device__ __forceinline__ XcdBarrier xcd_barrier_post(unsigned* bar, volatile LAS unsigned* st) {
    XcdBarrier b; b.bar = bar; b.x = xb_xcc_id(); b.st = st;
    if (threadIdx.x == 0) (void)xb_add(&bar[XB_XCNT(b.x)], 1u);
    return b;
}
__device__ __forceinline__ void xcd_barrier_complete(unsigned* bar, unsigned x, unsigned& nloc, unsigned& nx) {
    const unsigned G = gridDim.x * gridDim.y * gridDim.z;
    unsigned sum, cnt, mine, sp = 0u;
    for (;;) {
        sum = 0u; cnt = 0u; mine = 0u;
#pragma unroll
        for (unsigned j = 0; j < 16; ++j) { const unsigned c = xb_ld(&bar[XB_XCNT(j)]); sum += c; cnt += (c > 0u) ? 1u : 0u; mine = (j == x) ? c : mine; }
        if (sum == G) break;
        __builtin_amdgcn_s_sleep(1);
        if ((++sp & 255u) == 0u) { if (xb_ld(&bar[XB_TMO])) break; if (sp > XB_SPIN_CAP) { atomicAdd(&bar[XB_TMO], 1u); break; } }
    }
    nloc = mine > 0u ? mine : 1u; nx = cnt > 0u ? cnt : 1u;
}

__device__ __forceinline__ void xcd_barrier(const XcdBarrier& b) {
    asm volatile("s_waitcnt vmcnt(0)" ::: "memory");
    __syncthreads();
    if (threadIdx.x == 0) {
        unsigned* bar = b.bar;
        __builtin_amdgcn_s_waitcnt(0);
        unsigned nloc = b.st[0], nx = b.st[1];
        if (nloc == 0u) { xcd_barrier_complete(bar, b.x, nloc, nx); b.st[0] = nloc; b.st[1] = nx; }
        const unsigned old = xb_add(&bar[XB_XSUB(b.x)], 1u);
        const unsigned gen = old / nloc;
        if (old + 1u == (gen + 1u) * nloc) {
            __builtin_amdgcn_fence(__ATOMIC_RELEASE, "agent");
            asm volatile("s_waitcnt vmcnt(0)" ::: "memory");
            const unsigned og = xb_add(&bar[XB_TOP], 1u);
            const unsigned tg = og / nx;
            if (og + 1u == (tg + 1u) * nx) xb_add(&bar[XB_TOPGEN], 1u);
            else XB_SPIN(xb_ld(&bar[XB_TOPGEN]) == tg, bar);
            __builtin_amdgcn_fence(__ATOMIC_ACQUIRE, "agent");
            xb_add(&bar[XB_XGEN(b.x)], 1u);
            asm volatile("s_waitcnt vmcnt(0)" ::: "memory");
        } else {
            XB_SPIN(xb_ld(&bar[XB_XGEN(b.x)]) == gen, bar);
            __builtin_amdgcn_fence(__ATOMIC_ACQUIRE, "agent");
            asm volatile("s_waitcnt vmcnt(0)" ::: "memory");
        }
    }
    __syncthreads();
}

__device__ __forceinline__ Args load_args() {
    Args r{};
#if defined(__HIP_DEVICE_COMPILE__)
    typedef __attribute__((address_space(4))) const Args* CArgs;
    CArgs q = (CArgs)__builtin_amdgcn_kernarg_segment_ptr(); asm volatile("" : "+s"(q));
#pragma unroll
    for (int i = 0; i < 22; ++i) r.in[i] = q->in[i];
    r.out = q->out; r.ws = q->ws; r.ph_lo = q->ph_lo; r.ph_hi = q->ph_hi;
#endif
    return r;
}
__global__ void __launch_bounds__(512, 2) fwd_mega(Args a_unused) {
    extern __shared__ __attribute__((aligned(16))) unsigned char lds_raw[];
    LAS unsigned char* L = (LAS unsigned char*)lds_raw;
    cg::grid_group grid = cg::this_grid();
    int lo, hi; unsigned* barw; { const Args a0 = load_args(); lo = a0.ph_lo; hi = a0.ph_hi; barw = (unsigned*)(a0.ws + WS_BAR); }
    if (threadIdx.x < 2) ((volatile LAS unsigned*)(L + LDS_MISC))[threadIdx.x] = 0u;
    __syncthreads();
    const XcdBarrier bar = xcd_barrier_post(barw, (volatile LAS unsigned*)(L + LDS_MISC));
    if (hi > 1000) grid.sync();
#define PHASE_VARS const Args a = load_args(); unsigned char* ws = a.ws; bf16_t* XN = (bf16_t*)(ws + WS_XN); const float* mod = (const float*)(ws + WS_MOD); (void)XN; (void)mod;
#define IN(k) (lo <= (k) && (k) < hi)
#define SEAM(k) do { if (IN(k) && IN((k) + 1)) xcd_barrier(bar); } while (0)
    if (IN(0)) { PHASE_VARS phase_prep(a, L); } SEAM(0);
    if (IN(1)) { PHASE_VARS phase_norm1(a, L, XN); } SEAM(1);
    if (IN(2)) { PHASE_VARS pg8::Gemm g{XN, (const bf16_t*)(ws + WS_WIN), MTOK, NP, D}; pg8::StaticOrder S; S.init(MTOK, NP, gridDim.x, blockIdx.x);
        pg8::EpiProj E{(bf16_t*)(ws + WS_P), (const float*)(ws + WS_C0), (const float*)(ws + WS_C1)};
        pg8::gemm_phase<pg8::EpiProj, pg8::StaticOrder, true, true>(L, g, S, E);
        if (gridDim.x == 256 && blockIdx.x >= 128) phase_prep_late(a, L, 128); else if (gridDim.x != 256) phase_prep_late(a, L, 0); } SEAM(2);
    if (IN(3)) { PHASE_VARS phase_scan_light(a, L); } SEAM(3);
    if (IN(4)) { PHASE_VARS phase_scan(a, L); } SEAM(4);
    if (IN(5)) { PHASE_VARS pg8::Gemm g{XN, (const bf16_t*)(ws + WS_WO), MTOK, D, D}; pg8::StaticOrder S; S.init(MTOK, D, gridDim.x, blockIdx.x);
        pg8::EpiResNorm<false> E{a.in[0], a.in[1], a.out, mod, 2048, 3072, 4096, a.in[9], XN, (float*)(ws + WS_SLOTS), (unsigned*)(ws + WS_CNT)};
        pg8::gemm_phase<pg8::EpiResNorm<false>, pg8::StaticOrder, true, true>(L, g, S, E); } SEAM(5);
    if (IN(6)) { PHASE_VARS pg8::Gemm g{XN, (const bf16_t*)(ws + WS_WUP), MP, FF2, D}; pg8::StaticOrder S; S.init(MP, FF2, gridDim.x, blockIdx.x);
        pg8::EpiPlain E{(bf16_t*)(ws + WS_U), FF2};
        pg8::gemm_phase<pg8::EpiPlain, pg8::StaticOrder, true, true>(L, g, S, E); } SEAM(6);
    if (IN(7)) { PHASE_VARS phase_conv_seq(a, L, (const bf16_t*)(ws + WS_U), (bf16_t*)(ws + WS_AFF)); } SEAM(7);
    if (IN(8)) { PHASE_VARS pg8::Gemm g{XN + (size_t)MP * D, (const bf16_t*)(ws + WS_WUP), MP, FF2, D}; pg8::StaticOrder S; S.init(MP, FF2, gridDim.x, blockIdx.x);
        pg8::EpiPlain E{(bf16_t*)(ws + WS_U), FF2};
        pg8::gemm_phase<pg8::EpiPlain, pg8::StaticOrder, true, true>(L, g, S, E); } SEAM(8);
    if (IN(9)) { PHASE_VARS phase_conv_grid4(a, L, (const bf16_t*)(ws + WS_U), (bf16_t*)(ws + WS_AFF) + (size_t)MP * FF); } SEAM(9);
    if (IN(10)) { PHASE_VARS pg8::Gemm g{(const bf16_t*)(ws + WS_AFF), (const bf16_t*)(ws + WS_WDN), MTOK, D, FF}; pg8::StaticOrder S; S.init(MTOK, D, gridDim.x, blockIdx.x);
        pg8::EpiResNorm<true> E{a.out, a.out + (size_t)MP * D, a.out, mod, 5120, 0, 0, a.in[21], nullptr, (float*)(ws + WS_SLOTS) + (size_t)MTOK * 4, (unsigned*)(ws + WS_CNT) + 64 * 64};
        pg8::gemm_phase<pg8::EpiResNorm<true>, pg8::StaticOrder, true, true>(L, g, S, E); } SEAM(10);
#undef IN
#undef SEAM
}

extern "C" void kernel_launch(void* const* d_in, const int* in_sizes, int n_in, void* d_out, int out_size, void* d_ws, size_t ws_size, hipStream_t stream) {
    static int grid = 0;
    if (grid == 0) {
        if (n_in != 22 || ws_size < WS_END) { fprintf(stderr, "kernel_launch: unexpected n_in %d / ws %zu\n", n_in, ws_size); grid = -1; return; }
        int dev = 0, cus = 0, per_cu = 0;
        (void)hipGetDevice(&dev); (void)hipDeviceGetAttribute(&cus, hipDeviceAttributeMultiprocessorCount, dev);
        if (hipFuncSetAttribute((const void*)fwd_mega, hipFuncAttributeMaxDynamicSharedMemorySize, LDS_BYTES) != hipSuccess) { fprintf(stderr, "hipFuncSetAttribute failed\n"); grid = -1; return; }
        if (hipOccupancyMaxActiveBlocksPerMultiprocessor(&per_cu, (const void*)fwd_mega, 512, LDS_BYTES) != hipSuccess || per_cu < 1) { fprintf(stderr, "occupancy query: %d\n", per_cu); grid = -1; return; }
        grid = cus;
        if (grid != 256) { fprintf(stderr, "kernel_launch: built for a 256-CU device (grid %d)\n", grid); grid = -1; return; }
    }
    if (grid < 0) return;
    if (hipMemsetAsync((char*)d_ws + WS_BAR, 0, 16384, stream) != hipSuccess) { fprintf(stderr, "kernel_launch: hipMemsetAsync failed\n"); return; }
    Args a{};
    for (int i = 0; i < 22; ++i) a.in[i] = (const float*)d_in[i];
    a.out = (float*)d_out; a.ws = (unsigned char*)d_ws;
#if MK_MULTI
    for (int p = 0; p < NPH; ++p) { a.ph_lo = p; a.ph_hi = p + 1; hipLaunchKernelGGL(fwd_mega, dim3(grid), dim3(512), LDS_BYTES, stream, a); }
#else
    a.ph_lo = 0; a.ph_hi = NPH;
    void* args[] = {&a};
    hipError_t e = hipLaunchCooperativeKernel((const void*)fwd_mega, dim3(grid), dim3(512), args, LDS_BYTES, stream);
    if (e != hipSuccess) fprintf(stderr, "cooperative launch failed: %s (grid %d)\n", hipGetErrorString(e), grid);
#endif
}
```

```cpp
#include <hip/hip_runtime.h>
#include <hip/hip_cooperative_groups.h>
#include <cstdio>
#include <cstdint>
namespace cg = cooperative_groups;
#ifndef MK_MULTI
#define MK_MULTI 0
#endif
namespace pg8 {
#define PG8_LAS __attribute__((address_space(3)))
typedef unsigned short bf16_t;
typedef short bf16x8 __attribute__((ext_vector_type(8)));
typedef float f32x4 __attribute__((ext_vector_type(4)));
typedef unsigned u32x4 __attribute__((ext_vector_type(4)));
typedef unsigned u32x2 __attribute__((ext_vector_type(2)));
constexpr int BM = 256, BK = 64, HALF = 128, HTB = HALF * BK * 2  , STAGE_BYTES = 8 * HTB, NXCD = 8, WGM = 8;

__host__ __device__ __forceinline__ int lds_byte(int r, int c) { const int st = (r >> 4) * 2 + (c >> 5), rr = r & 15, cc = c & 31, ob = rr * 64 + cc * 2; return st * 1024 + (ob ^ (((ob >> 9) & 1) << 5)); }
__host__ __device__ __forceinline__ void stage_rc(int b, int& R, int& C) { const int st = b / 1024, sb = b % 1024, swz = sb ^ (((sb >> 9) & 1) << 5); R = (st >> 1) * 16 + swz / 64; C = (st & 1) * 32 + (swz % 64) / 2; }
__host__ __device__ __forceinline__ int perm32(int rho) { const int n = rho >> 4, i = rho & 15; return 8 * (i >> 2) + 4 * n + (i & 3); }

struct Unit { int pm, pn; };
struct Gemm { const bf16_t* A; const bf16_t* Bt; int M, N, K; };

struct StaticOrder {
    int nM, nN, nwg, G, c;
    __host__ __device__ void init(int M, int N, int G_, int c_) { nM = M / BM; nN = N / BM; nwg = nM * nN; G = G_; c = c_; }
    __host__ __device__ bool next(int i, Unit& u) const {
        const long L = (long)i * G + c; if (L >= nwg) return false;
        int wgid = (int)L; { const int q = nwg / NXCD, r = nwg % NXCD, xcd = wgid % NXCD, off = wgid / NXCD; wgid = (xcd < r ? xcd * (q + 1) : r * (q + 1) + (xcd - r) * q) + off; }
        const int nig = WGM * nN, gid = wgid / nig, fm = gid * WGM, gsz = (nM - fm) < WGM ? (nM - fm) : WGM;
        u.pm = fm + ((wgid % nig) % gsz); u.pn = (wgid % nig) / gsz; return true;
    }
    __device__ __forceinline__ void a_ready(const Unit&) const {}
    __device__ __forceinline__ void done(const Unit&) const {}
};

__device__ __forceinline__ unsigned cvt_pk_bf16(float lo, float hi) { unsigned r; asm volatile("v_cvt_pk_bf16_f32 %0, %1, %2" : "=v"(r) : "v"(lo), "v"(hi)); return r; }
typedef float f32x2 __attribute__((ext_vector_type(2)));
typedef float f32x2_t __attribute__((ext_vector_type(2))); typedef __bf16 bf16x2_t __attribute__((ext_vector_type(2)));
__device__ __forceinline__ unsigned cvtpk(float lo, float hi) { f32x2_t v = {lo, hi}; bf16x2_t b = __builtin_convertvector(v, bf16x2_t); return __builtin_bit_cast(unsigned, b); }
__device__ __forceinline__ float fast_exp(float x) { return __builtin_amdgcn_exp2f(x * 1.4426950408889634f); }
__device__ __forceinline__ float fast_log(float x) { return __builtin_amdgcn_logf(x) * 0.6931471805599453f; }
__device__ __forceinline__ float fast_rcp(float x) { return __builtin_amdgcn_rcpf(x); }
__device__ __forceinline__ float silu_f(float x) { return x * fast_rcp(1.f + fast_exp(-x)); }

struct EpiPlain {
    static constexpr bool PERM = true, AFTER_DRAIN = false;
    bf16_t* O; int ldc;
    __device__ __forceinline__ void operator()(const f32x4 (&acc)[2][2][4][2], const Unit& u, int wr, int wc, int fr, int fq) const {
        const int row0 = u.pm * BM + wr * 64 + fr, col0 = u.pn * BM + wc * 32 + 8 * fq;
#pragma unroll
        for (int ai = 0; ai < 2; ++ai)
#pragma unroll
            for (int m = 0; m < 4; ++m) { bf16_t* rowp = O + (size_t)(row0 + ai * HALF + m * 16) * ldc + col0;
#pragma unroll
                for (int bj = 0; bj < 2; ++bj) { const f32x4 v0 = acc[ai][bj][m][0], v1 = acc[ai][bj][m][1];
                    u32x4 w; w.x = cvtpk(v0[0], v0[1]); w.y = cvtpk(v0[2], v0[3]); w.z = cvtpk(v1[0], v1[1]); w.w = cvtpk(v1[2], v1[3]);
                    *(u32x4*)(rowp + bj * HALF) = w; } }
    }
};
struct EpiProj {
    static constexpr bool PERM = true, AFTER_DRAIN = false;
    bf16_t* O; const float* c0; const float* c1;
    __device__ __forceinline__ void operator()(const f32x4 (&acc)[2][2][4][2], const Unit& u, int wr, int wc, int fr, int fq) const {
        const int row0 = u.pm * BM + wr * 64 + fr; const int pn = u.pn;
        const int kind = (pn == 0) ? 1 : ((pn == 4 || pn == 5 || pn == 14 || pn == 15) ? 2 : ((pn >= 8 && pn <= 11) ? 3 : (pn >= 16 ? 4 : 0)));
#pragma unroll
        for (int bj = 0; bj < 2; ++bj) {
            const int col = pn * BM + bj * HALF + wc * 32 + 8 * fq;
            f32x4 ca0 = {0.f, 0.f, 0.f, 0.f}, ca1 = ca0, cb0 = ca0, cb1 = ca0;
            if (kind >= 3) { ca0 = *(const f32x4*)(c0 + col); ca1 = *(const f32x4*)(c0 + col + 4); }
            if (kind == 3) { cb0 = *(const f32x4*)(c1 + col); cb1 = *(const f32x4*)(c1 + col + 4); }
#pragma unroll
            for (int ai = 0; ai < 2; ++ai)
#pragma unroll
                for (int m = 0; m < 4; ++m) {
                    f32x4 v0 = acc[ai][bj][m][0], v1 = acc[ai][bj][m][1];
                    if (kind == 1) { v0 = v0 * 0.125f; v1 = v1 * 0.125f; }
                    else if (kind == 2) {
#pragma unroll
                        for (int e = 0; e < 4; ++e) { v0[e] = silu_f(v0[e]); v1[e] = silu_f(v1[e]); } }
                    else if (kind == 3) {
#pragma unroll
                        for (int e = 0; e < 4; ++e) { v0[e] = fast_log(ca0[e] + cb0[e] * fast_rcp(1.f + fast_exp(-v0[e]))); v1[e] = fast_log(ca1[e] + cb1[e] * fast_rcp(1.f + fast_exp(-v1[e]))); } }
                    else if (kind == 4) {
#pragma unroll
                        for (int e = 0; e < 4; ++e) { v0[e] = -0.0625f * fast_log(1.f + fast_exp(-(v0[e] + ca0[e]))); v1[e] = -0.0625f * fast_log(1.f + fast_exp(-(v1[e] + ca1[e]))); } }
                    u32x4 w; w.x = cvtpk(v0[0], v0[1]); w.y = cvtpk(v0[2], v0[3]); w.z = cvtpk(v1[0], v1[1]); w.w = cvtpk(v1[2], v1[3]);
                    *(u32x4*)(O + (size_t)(row0 + ai * HALF + m * 16) * 4608 + col) = w;
                }
        }
    }
};
struct EpiRes {
    static constexpr bool PERM = false, AFTER_DRAIN = false;
    const float* base0; const float* base1; float* out; const float* gate;
    __device__ __forceinline__ void operator()(const f32x4 (&acc)[2][2][4][2], const Unit& u, int wr, int wc, int fr, int fq) const {
        const int rt = u.pm * BM;
        const float* base = rt < 8192 ? base0 + (size_t)rt * 1024 : base1 + (size_t)(rt - 8192) * 1024;
        const float* g = gate + (rt < 8192 ? 0 : 1 + ((rt - 8192) >> 11)) * 6144;
        float* o = out + (size_t)rt * 1024;
        const int col0 = u.pn * BM + wc * 32 + 4 * fq;
#pragma unroll
        for (int bj = 0; bj < 2; ++bj)
#pragma unroll
            for (int n = 0; n < 2; ++n) { const int col = col0 + bj * HALF + n * 16; const f32x4 g4 = *(const f32x4*)(g + col);
#pragma unroll
                for (int ai = 0; ai < 2; ++ai)
#pragma unroll
                    for (int m = 0; m < 4; ++m) { const size_t off = (size_t)(ai * HALF + wr * 64 + m * 16 + fr) * 1024 + col;
                        const f32x4 b = *(const f32x4*)(base + off); *(f32x4*)(o + off) = b + g4 * acc[ai][bj][m][n]; } }
    }
};

template <bool FINAL> struct EpiResNorm {
    static constexpr bool PERM = false, AFTER_DRAIN = true;
    static constexpr int LROW = 260;
    const float* base0; const float* base1; float* out; const float* mod; int gate_off, shift_off, scale_off; const float* gvec; bf16_t* XN; float* slots; unsigned* cnt;
    __device__ __forceinline__ void fused(f32x4 (&acc)[2][2][4][2], const Unit& u, int wr, int wc, int fr, int fq, PG8_LAS unsigned char* lds, int wid, int lane) const {
        const int rt = u.pm * BM;
        const float* base = rt < 8192 ? base0 + (size_t)rt * 1024 : base1 + (size_t)(rt - 8192) * 1024;
        const float* mv = mod + (rt < 8192 ? 0 : 1 + ((rt - 8192) >> 11)) * 6144;
        float* o = out + (size_t)rt * 1024;
        const int col0 = u.pn * BM + wc * 32 + 4 * fq;
        PG8_LAS float* T = (PG8_LAS float*)lds;
        PG8_LAS float* Pp = T + 128 * LROW; PG8_LAS float* Sr = Pp + 1024;
        const int lbase = (wr * 64 + fr) * LROW + wc * 32 + 4 * fq;
        float ss[2][4];
#pragma unroll
        for (int ai = 0; ai < 2; ++ai)
#pragma unroll
            for (int m = 0; m < 4; ++m) ss[ai][m] = 0.f;
#pragma unroll
        for (int bj = 0; bj < 2; ++bj)
#pragma unroll
            for (int n = 0; n < 2; ++n) { const int col = col0 + bj * HALF + n * 16; const f32x4 g4 = *(const f32x4*)(mv + gate_off + col);
                f32x4 bv[2][4];
#pragma unroll
                for (int ai = 0; ai < 2; ++ai)
#pragma unroll
                    for (int m = 0; m < 4; ++m) bv[ai][m] = *(const f32x4*)(base + (size_t)(ai * HALF + wr * 64 + m * 16 + fr) * 1024 + col);
#pragma unroll
                for (int ai = 0; ai < 2; ++ai)
#pragma unroll
                    for (int m = 0; m < 4; ++m) { const size_t off = (size_t)(ai * HALF + wr * 64 + m * 16 + fr) * 1024 + col;
                        const f32x4 v = bv[ai][m] + g4 * acc[ai][bj][m][n];
                        if (!FINAL) *(f32x4*)(o + off) = v;
                        ss[ai][m] += (v[0] * v[0] + v[1] * v[1]) + (v[2] * v[2] + v[3] * v[3]);
                        if (ai == 0) *(PG8_LAS f32x4*)(T + lbase + m * 16 * LROW + bj * HALF + n * 16) = v; else acc[1][bj][m][n] = v; } }
#pragma unroll
        for (int ai = 0; ai < 2; ++ai)
#pragma unroll
            for (int m = 0; m < 4; ++m) { float s = ss[ai][m]; s += __shfl_xor(s, 16); s += __shfl_xor(s, 32);
                if (fq == 0) Pp[(ai * HALF + wr * 64 + m * 16 + fr) * 4 + wc] = s; }
        __syncthreads();
        const int tid = wid * 64 + lane;
        if (tid < 256) { const f32x4 p = *(const PG8_LAS f32x4*)(Pp + tid * 4);
            __hip_atomic_store(slots + (size_t)(rt + tid) * 4 + u.pn, (p[0] + p[1]) + (p[2] + p[3]), __ATOMIC_RELAXED, __HIP_MEMORY_SCOPE_AGENT); }
        asm volatile("s_waitcnt vmcnt(0)" ::: "memory");
        __syncthreads();
        if (tid == 0) { unsigned* c = cnt + 64 * u.pm; __hip_atomic_fetch_add(c, 1u, __ATOMIC_RELAXED, __HIP_MEMORY_SCOPE_AGENT);
            for (unsigned sp = 0; sp < (1u << 24); ++sp) { if (__hip_atomic_load(c, __ATOMIC_RELAXED, __HIP_MEMORY_SCOPE_AGENT) >= 4u) break; __builtin_amdgcn_s_sleep(1); } }
        __syncthreads();
        if (tid < 256) { float t = 0.f;
#pragma unroll
            for (int q = 0; q < 4; ++q) t += __hip_atomic_load(slots + (size_t)(rt + tid) * 4 + q, __ATOMIC_RELAXED, __HIP_MEMORY_SCOPE_AGENT);
            Sr[tid] = rsqrtf(t * (1.f / 1024.f) + 1e-6f); }
        __syncthreads();
#pragma unroll
        for (int bj = 0; bj < 2; ++bj)
#pragma unroll
            for (int n = 0; n < 2; ++n) { const int col = col0 + bj * HALF + n * 16; const f32x4 gg = *(const f32x4*)(gvec + col);
                f32x4 sc = {0.f, 0.f, 0.f, 0.f}, sh = sc; if (!FINAL) { sc = *(const f32x4*)(mv + scale_off + col) + 1.f; sh = *(const f32x4*)(mv + shift_off + col); }
#pragma unroll
                for (int ai = 0; ai < 2; ++ai)
#pragma unroll
                    for (int m = 0; m < 4; ++m) { const int r = ai * HALF + wr * 64 + m * 16 + fr; const float rs = Sr[r];
                        const f32x4 v = ai == 0 ? *(const PG8_LAS f32x4*)(T + lbase + m * 16 * LROW + bj * HALF + n * 16) : acc[1][bj][m][n];
                        if (FINAL) *(f32x4*)(o + (size_t)r * 1024 + col) = v * rs * gg;
                        else { const f32x4 h = v * rs * gg * sc + sh; u32x2 w; w.x = cvtpk(h[0], h[1]); w.y = cvtpk(h[2], h[3]); *(u32x2*)(XN + (size_t)(rt + r) * 1024 + col) = w; } } }
    }
};
template <class Epi, class Sched, bool ALIGN_EPI = false, bool SP2 = false>
__device__ __forceinline__ void gemm_phase(PG8_LAS unsigned char* lds, const Gemm g, const Sched& S, const Epi& E) {
    const int tid = threadIdx.x, wid = __builtin_amdgcn_readfirstlane(tid >> 6), lane = tid & 63, wr = wid >> 2, wc = wid & 3, fr = lane & 15, fq = lane >> 4;
    const int K = g.K, nt = K / BK;
    unsigned voffA[2], voffB[2];
#pragma unroll
    for (int i = 0; i < 2; ++i) { int R, C; stage_rc(tid * 16 + i * 8192, R, C); const int Rb = Epi::PERM ? ((R & ~31) + perm32(R & 31)) : R;
        voffA[i] = (unsigned)(R * K + C) * 2u; voffB[i] = (unsigned)(Rb * K + C) * 2u; }
    const size_t kstep = (size_t)(BK * 2);
    const size_t hstep = (size_t)HALF * K * 2;
    const size_t tstep = 2 * hstep;
    const unsigned ldsw = (unsigned)wid * 1024u;
    const int aoff = lds_byte(wr * 64 + fr, fq * 8), boff = lds_byte(wc * 32 + fr, fq * 8);
#define PG8_SA(b, h) (((b) * 2 + (h)) * HTB)
#define PG8_SB(b, h) ((4 + (b) * 2 + (h)) * HTB)
#define PG8_STAGE(bufoff, gbase, voff) do { _Pragma("unroll") for (int _i = 0; _i < 2; ++_i) \
        __builtin_amdgcn_global_load_lds((const unsigned*)((const char*)(gbase) + (voff)[_i]), (PG8_LAS unsigned*)(lds + (bufoff) + ldsw + _i * 8192), 16, 0, 0); } while (0)
#define PG8_LDA(dst, b, h) do { _Pragma("unroll") for (int m = 0; m < 4; ++m) _Pragma("unroll") for (int k = 0; k < 2; ++k) dst[m][k] = *(const PG8_LAS bf16x8*)(lds + PG8_SA(b, h) + aoff + m * 2048 + k * 1024); } while (0)
#define PG8_LDB(dst, b, h) do { _Pragma("unroll") for (int n = 0; n < 2; ++n) _Pragma("unroll") for (int k = 0; k < 2; ++k) dst[n][k] = *(const PG8_LAS bf16x8*)(lds + PG8_SB(b, h) + boff + n * 2048 + k * 1024); } while (0)
#define PG8_MMA(ai, bj, At, Bt) do { __builtin_amdgcn_s_setprio(1); _Pragma("unroll") for (int m = 0; m < 4; ++m) _Pragma("unroll") for (int n = 0; n < 2; ++n) _Pragma("unroll") for (int k = 0; k < 2; ++k) \
        acc[ai][bj][m][n] = __builtin_amdgcn_mfma_f32_16x16x32_bf16(Bt[n][k], At[m][k], acc[ai][bj][m][n], 0, 0, 0); __builtin_amdgcn_s_setprio(0); } while (0)
#define PG8_WAIT_V(n) asm volatile("s_waitcnt vmcnt(" #n ")" ::: "memory")
#define PG8_WAIT_L(n) asm volatile("s_waitcnt lgkmcnt(" #n ")" ::: "memory")
#define PG8_BAR __builtin_amdgcn_s_barrier()
#define PG8_SCHED __builtin_amdgcn_sched_barrier(0)
    Unit cur, nxt; int ui = 0;
    if (!S.next(0, cur)) return;
    f32x4 acc[2][2][4][2];
#pragma unroll
    for (int a = 0; a < 2; ++a)
#pragma unroll
        for (int b = 0; b < 2; ++b)
#pragma unroll
            for (int m = 0; m < 4; ++m)
#pragma unroll
                for (int n = 0; n < 2; ++n) acc[a][b][m][n] = (f32x4){0.f, 0.f, 0.f, 0.f};
    bf16x8 At[4][2], B0[2][2], B1[2][2];
    const char* cA = (const char*)g.A + (size_t)cur.pm * tstep; const char* cB = (const char*)g.Bt + (size_t)cur.pn * tstep;
    S.a_ready(cur);
    if constexpr (SP2) {
        PG8_STAGE(PG8_SB(0, 0), cB, voffB); PG8_STAGE(PG8_SB(0, 1), cB + hstep, voffB); PG8_STAGE(PG8_SA(0, 0), cA, voffA); PG8_STAGE(PG8_SA(0, 1), cA + hstep, voffA);
        if (wr == 1) PG8_BAR;
        PG8_WAIT_V(2); PG8_BAR;
        PG8_STAGE(PG8_SB(1, 0), cB + kstep, voffB); PG8_STAGE(PG8_SA(1, 0), cA + kstep, voffA); PG8_STAGE(PG8_SB(1, 1), cB + hstep + kstep, voffB);
        PG8_WAIT_V(6); PG8_BAR;
    } else {
        PG8_STAGE(PG8_SB(0, 0), cB, voffB); PG8_STAGE(PG8_SA(0, 0), cA, voffA); PG8_STAGE(PG8_SB(0, 1), cB + hstep, voffB); PG8_STAGE(PG8_SA(0, 1), cA + hstep, voffA);
        if (wr == 1) PG8_BAR;
        PG8_WAIT_V(4); PG8_BAR;
        PG8_STAGE(PG8_SB(1, 0), cB + kstep, voffB); PG8_STAGE(PG8_SA(1, 0), cA + kstep, voffA); PG8_STAGE(PG8_SB(1, 1), cB + hstep + kstep, voffB);
        PG8_WAIT_V(6); PG8_BAR;
    }
    for (;;) {
        const bool has_next = S.next(ui + 1, nxt);
        const char* nA = has_next ? (const char*)g.A + (size_t)nxt.pm * tstep : cA; const char* nB = has_next ? (const char*)g.Bt + (size_t)nxt.pn * tstep : cB;
        for (int t = 0; t < nt; t += 2) {
            const bool last = (t == nt - 2);
            const char* a1 = cA + (size_t)(t + 1) * kstep;
            const char* a2 = last ? nA : cA + (size_t)(t + 2) * kstep; const char* b2 = last ? nB : cB + (size_t)(t + 2) * kstep;
            const char* a3 = a2 + kstep; const char* b3 = b2 + kstep;
            if (last && has_next) S.a_ready(nxt);
            if constexpr (SP2) {
            PG8_LDB(B0, 0, 0); PG8_LDB(B1, 0, 1); PG8_SCHED; PG8_LDA(At, 0, 0); PG8_STAGE(PG8_SA(1, 1), a1 + hstep, voffA);
            PG8_WAIT_V(8); PG8_WAIT_L(0); PG8_BAR; PG8_MMA(0, 0, At, B0); PG8_MMA(0, 1, At, B1); PG8_BAR; PG8_SCHED;
            PG8_LDA(At, 0, 1); PG8_STAGE(PG8_SB(0, 0), b2, voffB); PG8_STAGE(PG8_SB(0, 1), b2 + hstep, voffB); PG8_STAGE(PG8_SA(0, 0), a2, voffA);
            PG8_WAIT_V(8); PG8_WAIT_L(0); PG8_BAR; PG8_MMA(1, 0, At, B0); PG8_MMA(1, 1, At, B1); PG8_BAR; PG8_SCHED;
            PG8_LDB(B0, 1, 0); PG8_LDB(B1, 1, 1); PG8_SCHED; PG8_LDA(At, 1, 0); PG8_STAGE(PG8_SA(0, 1), a2 + hstep, voffA);
            PG8_WAIT_V(8); PG8_WAIT_L(0); PG8_BAR; PG8_MMA(0, 0, At, B0); PG8_MMA(0, 1, At, B1); PG8_BAR; PG8_SCHED;
            PG8_LDA(At, 1, 1); PG8_STAGE(PG8_SB(1, 0), b3, voffB); PG8_STAGE(PG8_SB(1, 1), b3 + hstep, voffB); PG8_STAGE(PG8_SA(1, 0), a3, voffA);
            PG8_WAIT_V(8); PG8_WAIT_L(0); PG8_BAR; PG8_MMA(1, 0, At, B0); PG8_MMA(1, 1, At, B1); PG8_BAR; PG8_SCHED;
            } else {
            PG8_LDB(B0, 0, 0); PG8_SCHED; PG8_LDA(At, 0, 0); PG8_STAGE(PG8_SA(1, 1), a1 + hstep, voffA);
            PG8_WAIT_L(8); PG8_BAR; PG8_WAIT_L(0); PG8_MMA(0, 0, At, B0); PG8_BAR; PG8_SCHED;
            PG8_LDB(B1, 0, 1); PG8_STAGE(PG8_SB(0, 0), b2, voffB);
            PG8_BAR; PG8_WAIT_L(0); PG8_MMA(0, 1, At, B1); PG8_BAR;
            PG8_LDA(At, 0, 1); PG8_STAGE(PG8_SA(0, 0), a2, voffA);
            PG8_BAR; PG8_WAIT_L(0); PG8_MMA(1, 0, At, B0); PG8_BAR; PG8_SCHED;
            PG8_STAGE(PG8_SB(0, 1), b2 + hstep, voffB);
            PG8_WAIT_V(6); PG8_BAR; PG8_MMA(1, 1, At, B1); PG8_BAR;
            PG8_LDB(B0, 1, 0); PG8_SCHED; PG8_LDA(At, 1, 0); PG8_STAGE(PG8_SA(0, 1), a2 + hstep, voffA);
            PG8_WAIT_L(8); PG8_BAR; PG8_WAIT_L(0); PG8_MMA(0, 0, At, B0); PG8_BAR; PG8_SCHED;
            PG8_LDB(B1, 1, 1); PG8_STAGE(PG8_SB(1, 0), b3, voffB);
            PG8_BAR; PG8_WAIT_L(0); PG8_MMA(0, 1, At, B1); PG8_BAR;
            PG8_LDA(At, 1, 1); PG8_STAGE(PG8_SA(1, 0), a3, voffA);
            PG8_BAR; PG8_WAIT_L(0); PG8_MMA(1, 0, At, B0); PG8_BAR; PG8_SCHED;
            PG8_STAGE(PG8_SB(1, 1), b3 + hstep, voffB);
            PG8_WAIT_V(6); PG8_BAR; PG8_MMA(1, 1, At, B1); PG8_BAR;
            }
        }
        if constexpr (ALIGN_EPI) { if (wr == 0) PG8_BAR; }
        if constexpr (!Epi::AFTER_DRAIN) { E(acc, cur, wr, wc, fr, fq); S.done(cur); }
        if (!has_next) break;
#pragma unroll
        for (int a = 0; a < 2; ++a)
#pragma unroll
            for (int b = 0; b < 2; ++b)
#pragma unroll
                for (int m = 0; m < 4; ++m)
#pragma unroll
                    for (int n = 0; n < 2; ++n) acc[a][b][m][n] = (f32x4){0.f, 0.f, 0.f, 0.f};
        cur = nxt; cA = nA; cB = nB; ++ui;
        if constexpr (ALIGN_EPI) { if (wr == 1) PG8_BAR; }
    }
    PG8_WAIT_V(0);
    if constexpr (!ALIGN_EPI) { if (wr == 0) PG8_BAR; }
    PG8_BAR;
    if constexpr (Epi::AFTER_DRAIN) { E.fused(acc, cur, wr, wc, fr, fq, lds, wid, lane); S.done(cur); }
#undef PG8_SA
#undef PG8_SB
#undef PG8_STAGE
#undef PG8_LDA
#undef PG8_LDB
#undef PG8_MMA
#undef PG8_WAIT_V
#undef PG8_WAIT_L
#undef PG8_BAR
#undef PG8_SCHED
}
}
#define LAS __attribute__((address_space(3)))
typedef unsigned short bf16_t;
typedef float f32x4 __attribute__((ext_vector_type(4)));
typedef unsigned u32x4 __attribute__((ext_vector_type(4)));
typedef unsigned u32x2 __attribute__((ext_vector_type(2)));
typedef short bf16x8 __attribute__((ext_vector_type(8)));
typedef short s16x4 __attribute__((ext_vector_type(4)));
using pg8::f32x2_t; using pg8::cvtpk; using pg8::fast_exp; using pg8::fast_log; using pg8::fast_rcp; using pg8::silu_f;

constexpr int D = 1024, MTOK = 16384, MP = 8192, NP = 4608, FF = 2816, FF2 = 5632, INW = 4128, NMOD = 6144;
constexpr float EPS = 1e-6f;
constexpr size_t MiB = 1u << 20;
constexpr size_t WS_MOD = 0, WS_C0 = 256 * 1024, WS_C1 = 512 * 1024, WS_PART = 1 * MiB, WS_WIN = 2 * MiB, WS_WO = 11 * MiB, WS_WUP = 13 * MiB, WS_WDN = 24 * MiB,
                 WS_XN = 30 * MiB, WS_P = 62 * MiB, WS_U = 62 * MiB, WS_AFF = 150 * MiB, WS_END = 240 * MiB;
constexpr size_t WS_CNT = 768 * 1024, WS_SLOTS = 239 * MiB;
constexpr size_t WS_BAR = 832 * 1024;
constexpr int LDS_BYTES = 163840, LDS_MISC = 163840 - 64;
constexpr int NPH = 11;

__device__ __forceinline__ float bf_lo(unsigned u) { return __uint_as_float(u << 16); }
__device__ __forceinline__ float bf_hi(unsigned u) { return __uint_as_float(u & 0xffff0000u); }
__device__ __forceinline__ float wave_sum(float v) {
#pragma unroll
    for (int o = 1; o < 64; o <<= 1) v += __shfl_xor(v, o);
    return v;
}

struct Args { const float* in[22]; float* out; unsigned char* ws; int ph_lo, ph_hi; };

__device__ __forceinline__ void tr_store(bf16_t* WT, int K, int dst_row0, int k0, LAS float* scr, int lane) {
    asm volatile("s_waitcnt lgkmcnt(0)" ::: "memory");
    const int c = lane & 7;
#pragma unroll
    for (int j = 0; j < 4; ++j) { const int n = (lane >> 3) + 8 * j; const LAS float* s = scr + (8 * c) * 33 + n;
        u32x4 o; o.x = cvtpk(s[0 * 33], s[1 * 33]); o.y = cvtpk(s[2 * 33], s[3 * 33]); o.z = cvtpk(s[4 * 33], s[5 * 33]); o.w = cvtpk(s[6 * 33], s[7 * 33]);
        *(u32x4*)(WT + (size_t)(dst_row0 + n) * K + k0 + 8 * c) = o; }
    asm volatile("s_waitcnt lgkmcnt(0)" ::: "memory");
}
__device__ __forceinline__ void tr_item(const float* W, int ldw, int src_col0, bf16_t* WT, int K, int dst_row0, int k0, LAS float* scr, int lane) {
#pragma unroll 8
    for (int i = 0; i < 32; ++i) { const int kk = 2 * i + (lane >> 5); scr[kk * 33 + (lane & 31)] = W[(size_t)(k0 + kk) * ldw + src_col0 + (lane & 31)]; }
    tr_store(WT, K, dst_row0, k0, scr, lane);
}
__device__ __forceinline__ void tr_item_alpha(const float* Win, const float* Wup, bf16_t* WT, int nb, int k0, LAS float* scr, int lane) {
    const int n0 = 32 * nb, dir = n0 >> 8, kc = (n0 & 255) + (lane & 31);
    float up[16];
#pragma unroll
    for (int r = 0; r < 16; ++r) up[r] = Wup[(dir * 16 + r) * 256 + kc];
    for (int i = 0; i < 32; ++i) { const int kk = 2 * i + (lane >> 5); const f32x4* wr = (const f32x4*)(Win + (size_t)(k0 + kk) * INW + 1536 + dir * 16);
        float s = 0.f;
#pragma unroll
        for (int q = 0; q < 4; ++q) { const f32x4 w = wr[q]; s += w[0] * up[4 * q] + w[1] * up[4 * q + 1] + w[2] * up[4 * q + 2] + w[3] * up[4 * q + 3]; }
        scr[kk * 33 + (lane & 31)] = s; }
    tr_store(WT, 1024, 4096 + n0, k0, scr, lane);
}

__device__ __forceinline__ void phase_prep(const Args& a, LAS unsigned char* L) {
    const int tid = threadIdx.x, lane = tid & 63, wave = tid >> 6;
    LAS float* scr = (LAS float*)(L + wave * 8704);
    LAS float* sc = (LAS float*)(L + 8 * 8704);
    for (int i = tid; i < 5 * 1024; i += 512) { const int v = i >> 10, k = i & 1023; const float x = v == 0 ? a.in[5][k] : a.in[4][(v - 1) * 1024 + k]; sc[i] = x / (1.f + __expf(-x)); }
    __syncthreads();
    bf16_t* WinT = (bf16_t*)(a.ws + WS_WIN); bf16_t* WoT = (bf16_t*)(a.ws + WS_WO); bf16_t* WupT = (bf16_t*)(a.ws + WS_WUP); bf16_t* WdnT = (bf16_t*)(a.ws + WS_WDN);
    float* part = (float*)(a.ws + WS_PART);
    if (blockIdx.x == 0 && tid < 128) ((unsigned*)(a.ws + WS_CNT))[tid * 64] = 0u;
    const int gw = blockIdx.x * 8 + wave, NGW = gridDim.x * 8;
    constexpr int I_MOD = 96 * 8, I_IN = 16 * 128, I_AL = 16 * 16, I_O = 16 * 32, I_UP = 16 * 176, I_DN = 44 * 32;
    constexpr int NIT = I_MOD + I_IN + I_AL;
    for (int it = gw; it < NIT; it += NGW) {
        int r = it;
        if (r < I_MOD) {
            const int cb = r >> 3, ks = r & 7, col = 64 * cb + lane; const float* w = a.in[6] + (size_t)(128 * ks) * NMOD + col;
            float acc[5] = {0.f, 0.f, 0.f, 0.f, 0.f};
            for (int k = 0; k < 128; k += 16) { float wv[16];
#pragma unroll
                for (int j = 0; j < 16; ++j) wv[j] = w[(size_t)(k + j) * NMOD];
#pragma unroll
                for (int j = 0; j < 16; ++j)
#pragma unroll
                    for (int v = 0; v < 5; ++v) acc[v] += sc[v * 1024 + 128 * ks + k + j] * wv[j]; }
#pragma unroll
            for (int v = 0; v < 5; ++v) part[(size_t)(ks * 5 + v) * NMOD + col] = acc[v];
            continue; }
        r -= I_MOD;
        if (r < I_IN) { const int kb = r >> 7, nb = r & 127, n0 = 32 * nb; tr_item(a.in[10], INW, n0 + (n0 >= 1536 ? 32 : 0), WinT, 1024, n0, 64 * kb, scr, lane); continue; }
        r -= I_IN;
        tr_item_alpha(a.in[10], a.in[11], WinT, r & 15, 64 * (r >> 4), scr, lane);
    }
}
__device__ __forceinline__ void phase_prep_late(const Args& a, LAS unsigned char* L, int nb0) {
    const int tid = threadIdx.x, lane = tid & 63, wave = tid >> 6;
    LAS float* scr = (LAS float*)(L + wave * 8704);
    bf16_t* WoT = (bf16_t*)(a.ws + WS_WO); bf16_t* WupT = (bf16_t*)(a.ws + WS_WUP); bf16_t* WdnT = (bf16_t*)(a.ws + WS_WDN);
    constexpr int I_O = 16 * 32, I_UP = 16 * 176, I_DN = 44 * 32;
    const int gw = ((int)blockIdx.x - nb0) * 8 + wave, NGW = ((int)gridDim.x - nb0) * 8;
    for (int it = gw; it < I_O + I_UP + I_DN; it += NGW) {
        int r = it;
        if (r < I_O) { tr_item(a.in[16], 1024, 32 * (r & 31), WoT, 1024, 32 * (r & 31), 64 * (r >> 5), scr, lane); continue; }
        r -= I_O;
        if (r < I_UP) { const int kb = r / 176, nb = r % 176; tr_item(a.in[17], FF2, 32 * nb, WupT, 1024, 32 * nb, 64 * kb, scr, lane); continue; }
        r -= I_UP;
        { const int kb = r >> 5, nb = r & 31; tr_item(a.in[20], 1024, 32 * nb, WdnT, FF, 32 * nb, 64 * kb, scr, lane); }
    }
}
__device__ __forceinline__ void phase_modfin(const Args& a) {
    const int gt = blockIdx.x * 512 + threadIdx.x, NT = gridDim.x * 512;
    float* mod = (float*)(a.ws + WS_MOD); const float* part = (const float*)(a.ws + WS_PART);
    float* c0 = (float*)(a.ws + WS_C0); float* c1 = (float*)(a.ws + WS_C1);
    for (int i = gt; i < 5 * NMOD; i += NT) { const int v = i / NMOD, col = i % NMOD; float s = a.in[7][col];
#pragma unroll
        for (int ks = 0; ks < 8; ++ks) s += part[(size_t)(ks * 5 + v) * NMOD + col];
        mod[i] = s; }
    for (int i = gt; i < NP; i += NT) { float v0 = 0.f, v1 = 0.f;
        if (i >= 2048 && i < 3072) { const int j = i - 2048; const float a0 = a.in[13][j], a1 = a.in[13][1024 + j]; const float m = fmaxf(a0, a1);
            const float e0 = __expf(a0 - m), e1 = __expf(a1 - m), inv = 1.f / (e0 + e1); v0 = e0 * inv; v1 = e1 * inv; }
        else if (i >= 4096) v0 = a.in[12][i - 4096];
        c0[i] = v0; c1[i] = v1; }
}
__device__ __forceinline__ void phase_norm1(const Args& a, LAS unsigned char* L, bf16_t* XN) {
    phase_modfin(a);
    const int tid = threadIdx.x, lane = tid & 63, wave = tid >> 6;
    const int rbase = blockIdx.x * (MTOK / 256);
    const int mi = rbase < MP ? 0 : 1 + ((rbase - MP) >> 11);
    LAS float* lm = (LAS float*)L;
    const float* part = (const float*)(a.ws + WS_PART);
    __syncthreads();
#pragma unroll
    for (int j = 0; j < 4; ++j) { const int col = tid + 512 * j; float sacc = a.in[7][col];
#pragma unroll
        for (int ks = 0; ks < 8; ++ks) sacc += part[(size_t)(ks * 5 + mi) * NMOD + col];
        lm[col] = sacc; }
    __syncthreads();
    const float* g = a.in[8];
    for (int r = wave; r < MTOK / 256; r += 8) {
        const int row = rbase + r;
        const float* xr = row < MP ? a.in[0] + (size_t)row * D : a.in[1] + (size_t)(row - MP) * D;
        f32x4 v[4]; float sq = 0.f;
#pragma unroll
        for (int j = 0; j < 4; ++j) { v[j] = *(const f32x4*)(xr + 4 * lane + 256 * j); sq += (v[j][0] * v[j][0] + v[j][1] * v[j][1]) + (v[j][2] * v[j][2] + v[j][3] * v[j][3]); }
        const float rstd = rsqrtf(wave_sum(sq) * (1.f / D) + EPS);
#pragma unroll
        for (int j = 0; j < 4; ++j) { const int c = 4 * lane + 256 * j; const f32x4 gg = *(const f32x4*)(g + c), sc = *(const LAS f32x4*)(lm + 1024 + c), sh = *(const LAS f32x4*)(lm + c);
            const f32x4 h = v[j] * rstd * gg * (sc + 1.f) + sh; u32x2 o; o.x = cvtpk(h[0], h[1]); o.y = cvtpk(h[2], h[3]);
            *(u32x2*)(XN + (size_t)row * D + c) = o; }
    }
}
__device__ __forceinline__ void phase_final_norm(float* y, const float* g) {
    const int lane = threadIdx.x & 63, gw = blockIdx.x * 8 + (threadIdx.x >> 6), NGW = gridDim.x * 8;
    for (int row = gw; row < MTOK; row += NGW) {
        float* xr = y + (size_t)row * D; f32x4 v[4]; float s = 0.f;
#pragma unroll
        for (int j = 0; j < 4; ++j) { v[j] = *(const f32x4*)(xr + 4 * lane + 256 * j); s += (v[j][0] * v[j][0] + v[j][1] * v[j][1]) + (v[j][2] * v[j][2] + v[j][3] * v[j][3]); }
        const float rstd = rsqrtf(wave_sum(s) * (1.f / D) + EPS);
#pragma unroll
        for (int j = 0; j < 4; ++j) { const int c = 4 * lane + 256 * j; const f32x4 gg = *(const f32x4*)(g + c); *(f32x4*)(xr + c) = v[j] * rstd * gg; }
    }
}

constexpr size_t WS_SLOC = 206 * MiB, WS_DTOT = 238 * MiB;
static_assert(WS_P + (size_t)MTOK * NP * 2 <= WS_SLOC && WS_DTOT + 256 * 1024 <= 239 * MiB, "ws map");
template <int DK> struct ScanCfg {
    static constexpr int SA = DK == 128 ? 272 : 144, SV = 288;
    static constexpr int OFF_A = 0, OFF_B = 64 * SA, OFF_K = 128 * SA, OFF_V = 192 * SA, OFF_F = OFF_V + 64 * SV, OFF_R = OFF_F + 4 * DK * 4, OFF_L = OFF_R + 64 * 8 * 4, END = OFF_L + 64 * SA;
    static constexpr int OPITCH = 264, OFF_O = END;
    static_assert(OFF_O + 256 * OPITCH <= 163840 - 64, "LDS");
    static constexpr int NPAIR = DK / 2;
    static constexpr int NR = DK / 16, NK = DK / 32;
};
__device__ __forceinline__ s16x4 vtr(const LAS unsigned char* p) { return __builtin_bit_cast(s16x4, __builtin_amdgcn_ds_read_tr16_b64_v4i16((LAS s16x4*)p)); }

template <int DK, bool HG>
__device__ __forceinline__ void scan_load(u32x4 (&R)[HG ? 6 : 5], const bf16_t* P, int row0, int T, int dir, int sc, int qcol, int kcol, int lfcol, int vcol, int tid) {
    const bf16_t* pb = P + (size_t)(row0 + (dir ? T - 1 - 64 * sc : 64 * sc)) * NP;
#pragma unroll
    for (int j = 0; j < (HG ? 6 : 5); ++j) {
        int tl, col;
        if (HG) { const int p = (tid + 512 * j) & 1023; tl = p >> 4; col = (j < 2 ? qcol : (j < 4 ? lfcol : vcol)) + 8 * (p & 15); }
        else if (j < 3) { tl = tid >> 3; col = (j == 0 ? qcol : (j == 1 ? kcol : lfcol)) + 8 * (tid & 7); }
        else { const int p = tid + 512 * (j - 3); tl = p >> 4; col = vcol + 8 * (p & 15); }
        R[j] = *(const u32x4*)(pb + (dir ? -tl : tl) * NP + col);
    }
}
template <int DK, bool HG>
__device__ __forceinline__ void scan_stash(const u32x4 (&R)[HG ? 6 : 5], LAS unsigned char* L, int tid) {
    using C = ScanCfg<DK>;
#pragma unroll
    for (int j = 0; j < (HG ? 6 : 5); ++j) {
        int off;
        if (HG) { const int p = (tid + 512 * j) & 1023; const int tl = p >> 4, ch = p & 15; off = (j < 2 ? C::OFF_A + tl * C::SA : (j < 4 ? C::OFF_L + tl * C::SA : C::OFF_V + tl * C::SV)) + ch * 16; }
        else if (j < 3) { off = (j == 0 ? C::OFF_A : (j == 1 ? C::OFF_B : C::OFF_L)) + (tid >> 3) * C::SA + (tid & 7) * 16; }
        else { const int p = tid + 512 * (j - 3); off = C::OFF_V + (p >> 4) * C::SV + (p & 15) * 16; }
        *(LAS u32x4*)(L + off) = R[j];
    }
}
template <int DK, bool HG, bool LIGHT>
__device__ __forceinline__ void scan_item(LAS unsigned char* L, const bf16_t* P, float* OF, bf16_t* XN, int row0, int T,
                                          int qcol, int kcol, int lfcol_f, int lfcol_b, int vcol, int sgcol, int mcol,
                                          const float* s0f, const float* s0b, const float* cmb_s, const float* cmb_d, int seg, float* sof, float* sob, float* dtot, const float* gnorm) {
    using C = ScanCfg<DK>;
    const int tid = threadIdx.x, lane = tid & 63, wid = tid >> 6, fr = lane & 15, fq = lane >> 4, cb = wid * 16;
    const int nsc = T >> 6;
    const float gn = LIGHT ? 0.f : gnorm[cb + fr];
    for (int dir = 0; dir < 2; ++dir) {
        f32x4 S[C::NR], Dacc[LIGHT ? C::NR : 1];
        { const float* s0 = dir ? s0b : s0f;
#pragma unroll
          for (int r = 0; r < C::NR; ++r) { if (LIGHT) Dacc[r] = (f32x4){1.f, 1.f, 1.f, 1.f};
#pragma unroll
              for (int jj = 0; jj < 4; ++jj) S[r][jj] = s0 ? s0[(16 * r + fq * 4 + jj) * 128 + cb + fr] : 0.f; }
          if (cmb_s) {
              const int n = dir ? 7 - seg : seg;
              for (int q = 0; q < n; ++q) { const int sj = dir ? 7 - q : q;
                  const float* sl = cmb_s + (size_t)(sj * 2 + dir) * 16384; const float* dl = cmb_d + (size_t)(sj * 2 + dir) * 128;
#pragma unroll
                  for (int r = 0; r < C::NR; ++r) { const f32x4 dd = *(const f32x4*)(dl + 16 * r + fq * 4);
#pragma unroll
                      for (int jj = 0; jj < 4; ++jj) S[r][jj] = S[r][jj] * dd[jj] + sl[(16 * r + fq * 4 + jj) * 128 + cb + fr]; } } } }
        const int lfcol = dir ? lfcol_b : lfcol_f;
        u32x4 R[HG ? 6 : 5];
        scan_load<DK, HG>(R, P, row0, T, dir, 0, qcol, kcol, lfcol, vcol, tid);
#pragma unroll 1
        for (int sc = 0; sc < nsc; ++sc) {
            int tid_o = tid; asm volatile("" : "+v"(tid_o));
            const int fr_o = tid_o & 15, fq_o = (tid_o >> 4) & 3, cb_o = (tid_o >> 6) << 4;
            __syncthreads();
            scan_stash<DK, HG>(R, L, tid_o);
            if (sc + 1 < nsc) scan_load<DK, HG>(R, P, row0, T, dir, sc + 1, qcol, kcol, lfcol, vcol, tid_o);
            __syncthreads();
            {
                constexpr int NPARTS = 512 / (4 * C::NPAIR), RP = 16 / NPARTS;
                const int c = tid / (NPARTS * C::NPAIR), rem = tid % (NPARTS * C::NPAIR), part = rem / C::NPAIR, d0 = 2 * (rem % C::NPAIR);
                float g0[NPARTS], g1[NPARTS];
#pragma unroll
                for (int q = 0; q < NPARTS; ++q) { float a0 = 0.f, a1 = 0.f;
#pragma unroll
                    for (int i = 0; i < RP; ++i) { const unsigned u = *(const LAS unsigned*)(L + C::OFF_L + (16 * c + q * RP + i) * C::SA + d0 * 2); a0 += bf_lo(u); a1 += bf_hi(u); }
                    g0[q] = a0; g1[q] = a1; }
                float t0 = 0.f, t1 = 0.f, s0 = 0.f, s1 = 0.f;
#pragma unroll
                for (int q = 0; q < NPARTS; ++q) { t0 += g0[q]; t1 += g1[q]; if (q < part) { s0 += g0[q]; s1 += g1[q]; } }
                const float bl0 = fmaxf(t0, -80.f), bl1 = fmaxf(t1, -80.f);
                const float f0 = fast_exp(bl0), f1 = fast_exp(bl1);
                if (part == 0) *(LAS f32x2_t*)(L + C::OFF_F + (c * DK + d0) * 4) = (f32x2_t){f0, f1};
#pragma unroll
                for (int i = 0; i < RP; ++i) {
                    const int o = (16 * c + RP * part + i) * C::SA + d0 * 2;
                    const unsigned lu = *(const LAS unsigned*)(L + C::OFF_L + o);
                    s0 += bf_lo(lu); s1 += bf_hi(lu);
                    const float b0 = fmaxf(s0, -80.f), b1 = fmaxf(s1, -80.f);
                    float k0, k1;
                    if (HG) { k0 = 1.f - fast_exp(bf_lo(lu)); k1 = 1.f - fast_exp(bf_hi(lu)); }
                    else { const unsigned ku = *(const LAS unsigned*)(L + C::OFF_B + o); k0 = bf_lo(ku); k1 = bf_hi(ku); }
                    const float bq0 = k0 * fast_exp(-b0), bq1 = k1 * fast_exp(-b1);
                    if (!LIGHT) {
                        const unsigned qu = *(const LAS unsigned*)(L + C::OFF_A + o);
                        *(LAS unsigned*)(L + C::OFF_A + o) = cvtpk(bf_lo(qu) * fast_exp(b0), bf_hi(qu) * fast_exp(b1));
                        *(LAS unsigned*)(L + C::OFF_B + o) = cvtpk(bq0, bq1);
                    }
                    *(LAS unsigned*)(L + C::OFF_K + o) = cvtpk(bq0 * f0, bq1 * f1);
                }
            }
            __syncthreads();
            f32x4 obuf[4];
            LAS unsigned short* ol = (LAS unsigned short*)(L + C::OFF_O) + (dir ? 255 - 64 * sc - fq * 4 : 64 * sc + fq * 4) * (C::OPITCH / 2) + cb + fr;
#pragma unroll
            for (int c = 0; c < 4; ++c) {
                const s16x4 vb = vtr(L + C::OFF_V + (16 * c + fq * 4 + (fr >> 2)) * C::SV + (cb + 4 * (fr & 3)) * 2);
                f32x4 o = {0.f, 0.f, 0.f, 0.f};
                if (!LIGHT) {
                bf16x8 a1[C::NK], b1[C::NK];
                const LAS unsigned char* pa = L + C::OFF_A + (16 * c + fr) * C::SA + fq * 8;
                const LAS unsigned char* pb = L + C::OFF_B + (16 * c + fr) * C::SA + fq * 8;
#pragma unroll
                for (int kk = 0; kk < C::NK; ++kk) {
                    const s16x4 al = *(const LAS s16x4*)(pa + kk * 64), ah = *(const LAS s16x4*)(pa + kk * 64 + 32);
                    const s16x4 bl = *(const LAS s16x4*)(pb + kk * 64), bh = *(const LAS s16x4*)(pb + kk * 64 + 32);
                    a1[kk] = (bf16x8){al[0], al[1], al[2], al[3], ah[0], ah[1], ah[2], ah[3]};
                    b1[kk] = (bf16x8){bl[0], bl[1], bl[2], bl[3], bh[0], bh[1], bh[2], bh[3]};
                }
                f32x4 sT = {0.f, 0.f, 0.f, 0.f};
#pragma unroll
                for (int kk = 0; kk < C::NK; ++kk) sT = __builtin_amdgcn_mfma_f32_16x16x32_bf16(b1[kk], a1[kk], sT, 0, 0, 0);
#pragma unroll
                for (int jj = 0; jj < 4; ++jj) sT[jj] = (fq * 4 + jj <= fr) ? sT[jj] : 0.f;
                const unsigned p01 = cvtpk(sT[0], sT[1]), p23 = cvtpk(sT[2], sT[3]);
                const s16x4 pfrag = __builtin_bit_cast(s16x4, (u32x2){p01, p23});
                o = __builtin_amdgcn_mfma_f32_16x16x16bf16_1k(pfrag, vb, (f32x4){0.f, 0.f, 0.f, 0.f}, 0, 0, 0);
#pragma unroll
                for (int kk = 0; kk < C::NK; ++kk) {
                    const u32x4 sw = {cvtpk(S[2 * kk][0], S[2 * kk][1]), cvtpk(S[2 * kk][2], S[2 * kk][3]), cvtpk(S[2 * kk + 1][0], S[2 * kk + 1][1]), cvtpk(S[2 * kk + 1][2], S[2 * kk + 1][3])};
                    o = __builtin_amdgcn_mfma_f32_16x16x32_bf16(a1[kk], __builtin_bit_cast(bf16x8, sw), o, 0, 0, 0);
                }
                }
#pragma unroll
                for (int r = 0; r < C::NR; ++r) {
                    const f32x4 fc = *(const LAS f32x4*)(L + C::OFF_F + (c * DK + 16 * r + fq * 4) * 4);
                    const s16x4 ka = vtr(L + C::OFF_K + (16 * c + fq * 4 + (fr >> 2)) * C::SA + (16 * r + 4 * (fr & 3)) * 2);
                    S[r] = __builtin_amdgcn_mfma_f32_16x16x16bf16_1k(ka, vb, S[r] * fc, 0, 0, 0);
                    if (LIGHT) Dacc[r] = Dacc[r] * fc;
                }
#pragma unroll
                for (int jj = 0; jj < 4; ++jj) { if (LIGHT) continue;
                    if (dir == 0) ol[(16 * c + jj) * (C::OPITCH / 2)] = (unsigned short)(cvtpk(o[jj], o[jj]) & 0xffffu); else o[jj] += __uint_as_float((unsigned)ol[-(16 * c + jj) * (C::OPITCH / 2)] << 16); }
                obuf[c] = o;
            }
            if (!LIGHT && dir == 1) {
                unsigned sgp[4][2];
                { const bf16_t* gb = P + (size_t)(row0 + T - 1 - 64 * sc - fq_o * 4) * NP + sgcol + cb_o + fr_o;
#pragma unroll
                  for (int c = 0; c < 4; ++c)
#pragma unroll
                      for (int jj = 0; jj < 4; ++jj) { const unsigned sv = gb[-(16 * c + jj) * NP]; if (jj & 1) sgp[c][jj >> 1] |= sv << 16; else sgp[c][jj >> 1] = sv; } }
#pragma unroll
                for (int c = 0; c < 4; ++c)
#pragma unroll
                    for (int jj = 0; jj < 4; ++jj) { float ss = obuf[c][jj] * obuf[c][jj]; ss += __shfl_xor(ss, 1); ss += __shfl_xor(ss, 2); ss += __shfl_xor(ss, 4); ss += __shfl_xor(ss, 8);
                        if (fr == 0) *(LAS float*)(L + C::OFF_R + ((16 * c + fq * 4 + jj) * 8 + wid) * 4) = ss; }
                __syncthreads();
                bf16_t* xo = XN + (size_t)(row0 + T - 1 - 64 * sc - fq_o * 4) * D + mcol + cb_o + fr_o;
#pragma unroll
                for (int c = 0; c < 4; ++c)
#pragma unroll
                    for (int jj = 0; jj < 4; ++jj) { const int tl = 16 * c + fq * 4 + jj; const f32x4 r0 = *(const LAS f32x4*)(L + C::OFF_R + tl * 32), r1 = *(const LAS f32x4*)(L + C::OFF_R + tl * 32 + 16);
                        const float tot = ((r0[0] + r0[1]) + (r0[2] + r0[3])) + ((r1[0] + r1[1]) + (r1[2] + r1[3]));
                        const float rstd = rsqrtf(tot * (1.f / 128.f) + EPS);
                        const float sg = (jj & 1) ? bf_hi(sgp[c][jj >> 1]) : bf_lo(sgp[c][jj >> 1]);
                        const float val = obuf[c][jj] * rstd * gn * sg;
                        xo[-(16 * c + jj) * D] = (bf16_t)(cvtpk(val, val) & 0xffffu); }
            }
        }
        float* so = dir ? sob : sof;
        if (so) {
#pragma unroll
            for (int r = 0; r < C::NR; ++r)
#pragma unroll
                for (int jj = 0; jj < 4; ++jj) so[(16 * r + fq * 4 + jj) * 128 + cb + fr] = S[r][jj]; }
        if (LIGHT && wid == 0 && fr == 0) {
#pragma unroll
            for (int r = 0; r < C::NR; ++r) *(f32x4*)(dtot + dir * 128 + 16 * r + fq * 4) = Dacc[r]; }
    }
}

template <int DK, bool HG>
__device__ __forceinline__ void scan_light2(LAS unsigned char* L, const bf16_t* P, int row0, int kcol, int lfcol_f, int lfcol_b, int vcol, float* so_f, float* so_b, float* dtot) {
    constexpr int SA = DK * 2 + 32, SV = 288, NR = DK / 16, NPAIR = DK / 2;
    constexpr int OFF_L = 0, OFF_K = 128 * SA, OFF_V = 256 * SA, OFF_G = OFF_V + 128 * SV, OFF_F = OFF_G + 8 * DK * 4, OFF_T = OFF_F + DK * 4;
    static_assert(OFF_T + DK * 4 <= 147392, "LDS");
    const int tid0 = threadIdx.x;
#pragma unroll 1
    for (int dir = 0; dir < 2; ++dir) {
        const int lfcol = dir ? lfcol_b : lfcol_f;
        f32x4 S[NR];
#pragma unroll
        for (int r = 0; r < NR; ++r) S[r] = (f32x4){0.f, 0.f, 0.f, 0.f};
        u32x4 R[8];
#pragma unroll 1
        for (int st = 0; st < 2; ++st) {
            int tid = tid0; asm volatile("" : "+v"(tid));
            const int lane = tid & 63, wid = tid >> 6, fr = lane & 15, fq = lane >> 4, cb = wid * 16;
            {
                const bf16_t* pb = P + (size_t)(row0 + (dir ? 255 - 128 * st : 128 * st)) * NP;
#pragma unroll
                for (int j = 0; j < 8; ++j) {
                    int tl, col;
                    if (j >= 4) { const int p = tid + 512 * (j - 4); tl = p >> 4; col = vcol + 8 * (p & 15); }
                    else if (HG) { const int p = tid + 512 * j; tl = p >> 4; col = lfcol + 8 * (p & 15); }
                    else { const int p = tid + 512 * (j & 1); tl = p >> 3; col = (j < 2 ? lfcol : kcol) + 8 * (p & 7); }
                    R[j] = *(const u32x4*)(pb + (dir ? -tl : tl) * NP + col);
                }
            }
            __syncthreads();
#pragma unroll
            for (int j = 0; j < 8; ++j) {
                int off;
                if (j >= 4) { const int p = tid + 512 * (j - 4); off = OFF_V + (p >> 4) * SV + (p & 15) * 16; }
                else if (HG) { const int p = tid + 512 * j; off = OFF_L + (p >> 4) * SA + (p & 15) * 16; }
                else { const int p = tid + 512 * (j & 1); off = (j < 2 ? OFF_L : OFF_K) + (p >> 3) * SA + (p & 7) * 16; }
                *(LAS u32x4*)(L + off) = R[j];
            }
            __syncthreads();
            const bool act = tid < 8 * NPAIR;
            const int g = tid / NPAIR, d0 = 2 * (tid % NPAIR);
            unsigned lfv[16]; float s0 = 0.f, s1 = 0.f;
            if (act) {
#pragma unroll
                for (int i = 0; i < 16; ++i) { lfv[i] = *(const LAS unsigned*)(L + OFF_L + (16 * g + i) * SA + d0 * 2); s0 += bf_lo(lfv[i]); s1 += bf_hi(lfv[i]); }
                *(LAS f32x2_t*)(L + OFF_G + (g * DK + d0) * 4) = (f32x2_t){s0, s1};
            }
            __syncthreads();
            if (act) {
                float a0 = 0.f, a1 = 0.f;
#pragma unroll
                for (int gp = 1; gp < 8; ++gp) { const f32x2_t t = *(const LAS f32x2_t*)(L + OFF_G + (gp * DK + d0) * 4); if (gp > g) { a0 += t.x; a1 += t.y; } }
                if (g == 0) { const float t0 = s0 + a0, t1 = s1 + a1;
                    *(LAS f32x2_t*)(L + OFF_F + d0 * 4) = (f32x2_t){fast_exp(fmaxf(t0, -80.f)), fast_exp(fmaxf(t1, -80.f))};
                    LAS f32x2_t* tp = (LAS f32x2_t*)(L + OFF_T + d0 * 4); if (st == 0) *tp = (f32x2_t){t0, t1}; else { const f32x2_t o = *tp; *tp = (f32x2_t){o.x + t0, o.y + t1}; } }
#pragma unroll
                for (int i = 15; i >= 0; --i) {
                    const int o = (16 * g + i) * SA + d0 * 2;
                    float k0, k1;
                    if (HG) { k0 = 1.f - fast_exp(bf_lo(lfv[i])); k1 = 1.f - fast_exp(bf_hi(lfv[i])); }
                    else { const unsigned ku = *(const LAS unsigned*)(L + OFF_K + o); k0 = bf_lo(ku); k1 = bf_hi(ku); }
                    *(LAS unsigned*)(L + OFF_K + o) = cvtpk(k0 * fast_exp(fmaxf(a0, -80.f)), k1 * fast_exp(fmaxf(a1, -80.f)));
                    a0 += bf_lo(lfv[i]); a1 += bf_hi(lfv[i]);
                }
            }
            __syncthreads();
#pragma unroll
            for (int r = 0; r < NR; ++r) { const f32x4 fd = *(const LAS f32x4*)(L + OFF_F + (16 * r + fq * 4) * 4); S[r] = S[r] * fd; }
#pragma unroll
            for (int ks = 0; ks < 4; ++ks) {
                const int rb = 32 * ks + fq * 8 + (fr >> 2);
                const s16x4 vl = vtr(L + OFF_V + rb * SV + (cb + 4 * (fr & 3)) * 2), vh = vtr(L + OFF_V + (rb + 4) * SV + (cb + 4 * (fr & 3)) * 2);
                const bf16x8 vb = (bf16x8){vl[0], vl[1], vl[2], vl[3], vh[0], vh[1], vh[2], vh[3]};
#pragma unroll
                for (int r = 0; r < NR; ++r) {
                    const s16x4 kl = vtr(L + OFF_K + rb * SA + (16 * r + 4 * (fr & 3)) * 2), kh = vtr(L + OFF_K + (rb + 4) * SA + (16 * r + 4 * (fr & 3)) * 2);
                    const bf16x8 ka = (bf16x8){kl[0], kl[1], kl[2], kl[3], kh[0], kh[1], kh[2], kh[3]};
                    S[r] = __builtin_amdgcn_mfma_f32_16x16x32_bf16(ka, vb, S[r], 0, 0, 0);
                }
            }
            if (st == 1) {
                float* so = dir ? so_b : so_f;
#pragma unroll
                for (int r = 0; r < NR; ++r)
#pragma unroll
                    for (int jj = 0; jj < 4; ++jj) so[(16 * r + fq * 4 + jj) * 128 + cb + fr] = S[r][jj];
                if (tid < DK) dtot[dir * 128 + tid] = fast_exp(fmaxf(*(const LAS float*)(L + OFF_T + tid * 4), -80.f));
            }
        }
    }
}

__device__ __forceinline__ void phase_scan_light(const Args& a, LAS unsigned char* L) {
    const bf16_t* P = (const bf16_t*)(a.ws + WS_P);
    for (int j = blockIdx.x; j < 256; j += gridDim.x) {
        const int b = j >> 6, hh = (j >> 3) & 7, seg = j & 7, h = hh & 3, row0 = MP + b * 2048 + seg * 256;
        float* sl = (float*)(a.ws + WS_SLOC) + (size_t)j * 2 * 16384; float* dt = (float*)(a.ws + WS_DTOT) + (size_t)j * 2 * 128;
        if (hh < 4) scan_light2<64, false>(L, P, row0, 256 + h * 64, 4096 + h * 64, 4352 + h * 64, 512 + h * 128, sl, sl + 16384, dt);
        else scan_light2<128, true>(L, P, row0, 0, 2048 + h * 128, 2560 + h * 128, 3072 + h * 128, sl, sl + 16384, dt);
    }
}
__device__ __forceinline__ void phase_scan(const Args& a, LAS unsigned char* L) {
    const bf16_t* P = (const bf16_t*)(a.ws + WS_P); bf16_t* XN = (bf16_t*)(a.ws + WS_XN); float* OF = a.out;
    float* og = a.out + (size_t)MTOK * D; float* oh = og + 32 * 2 * 4 * 64 * 128;
    for (int j = blockIdx.x; j < 512; j += gridDim.x) {
        const bool samp = j >= 256; int b, hh, seg = 0, row0;
        if (samp) { const int q = j - 256;
            b = q >> 6; hh = ((((q >> 2) & 1) ^ 1) << 2) | ((q >> 3) & 3); seg = (((q >> 5) & 1) << 2) | (q & 3); row0 = MP + b * 2048 + seg * 256; } else { b = j >> 3; hh = j & 7; row0 = b * 256; }
        const int h = hh & 3;
        const int li0 = (b * 8 + hh) * 8;
        const float* cs = samp ? (const float*)(a.ws + WS_SLOC) + (size_t)li0 * 2 * 16384 : nullptr;
        const float* cd = samp ? (const float*)(a.ws + WS_DTOT) + (size_t)li0 * 2 * 128 : nullptr;
        if (hh < 4) {
            const size_t so = (size_t)(b * 2 * 4 + h) * 64 * 128, sd = (size_t)4 * 64 * 128;
            scan_item<64, false, false>(L, P, OF, XN, row0, 256, h * 64, 256 + h * 64, 4096 + h * 64, 4352 + h * 64, 512 + h * 128, 1024 + h * 128, h * 128,
                                       samp ? a.in[2] + so : nullptr, samp ? a.in[2] + so + sd : nullptr, cs, cd, seg, samp ? nullptr : og + so, samp ? nullptr : og + so + sd, nullptr, a.in[14]);
        } else {
            const size_t so = (size_t)(b * 2 * 4 + h) * 128 * 128, sd = (size_t)4 * 128 * 128;
            scan_item<128, true, false>(L, P, OF, XN, row0, 256, 1536 + h * 128, 0, 2048 + h * 128, 2560 + h * 128, 3072 + h * 128, 3584 + h * 128, 512 + h * 128,
                                       samp ? a.in[3] + so : nullptr, samp ? a.in[3] + so + sd : nullptr, cs, cd, seg, samp ? nullptr : oh + so, samp ? nullptr : oh + so + sd, nullptr, a.in[15]);
        }
    }
}

#define OPAQUE(p) asm volatile("" : "+v"(p))
template <bool GRID>
__device__ __forceinline__ void conv_load(u32x4 (&R)[GRID ? 13 : 5], u32x4 (&W)[2], const bf16_t* U, const float* cw, const float* cbias, int it, int tid) {
    constexpr int NR = GRID ? 3 : 1, NT = GRID ? 9 : 3, NPJ = GRID ? 13 : 5, TOT = NR * 66 * 32;
    const int span = it / 22, cb = it % 22;
    const bf16_t* ub = U + (size_t)span * 64 * FF2 + cb * 128; OPAQUE(ub);
#pragma unroll
    for (int j = 0; j < NPJ; ++j) {
        const int p = tid + 512 * j;
        const int rr = p / (66 * 32), rem = p % (66 * 32), s = rem >> 5, pc = rem & 31;
        bool ok; int roff;
        if (GRID) { const int r = (span & 31) + rr - 1; ok = (p < TOT) & (r >= 0) & (r < 32) & (s >= 1) & (s <= 64); roff = (rr - 1) * 64 + s - 1; }
        else { ok = (p < TOT) & (((s >= 1) & (s <= 64)) | ((s == 0) & ((span & 3) != 0)) | ((s == 65) & ((span & 3) != 3))); roff = s - 1; }
        const int off = ok ? roff * FF2 + (pc < 16 ? pc * 8 : FF + (pc - 16) * 8) : 0;
        u32x4 v = *(const u32x4*)(ub + off);
        const unsigned m = ok ? 0xffffffffu : 0u;
        v.x &= m; v.y &= m; v.z &= m; v.w &= m;
        R[j] = v;
    }
#pragma unroll
    for (int j = 0; j < 2; ++j) {
        const int p = tid + 512 * j;
        const bool isw = p < NT * 64; const int q = isw ? p : (p < NT * 64 + 64 ? p - NT * 64 : 0);
        const int tap = q >> 6, g = (q >> 5) & 1, c4 = q & 31;
        const float* src = isw ? cw + (size_t)(GRID ? tap : 3 + tap) * FF2 : cbias;
        W[j] = *(const u32x4*)(src + g * FF + cb * 128 + c4 * 4);
    }
}
__device__ __forceinline__ void conv_fma(float (&ag)[8], float (&au)[8], const u32x4 gv, const u32x4 uv, const LAS float* wg) {
    const f32x4 wg0 = *(const LAS f32x4*)wg, wg1 = *(const LAS f32x4*)(wg + 4), wu0 = *(const LAS f32x4*)(wg + 128), wu1 = *(const LAS f32x4*)(wg + 132);
    ag[0] += bf_lo(gv[0]) * wg0[0]; ag[1] += bf_hi(gv[0]) * wg0[1]; ag[2] += bf_lo(gv[1]) * wg0[2]; ag[3] += bf_hi(gv[1]) * wg0[3];
    ag[4] += bf_lo(gv[2]) * wg1[0]; ag[5] += bf_hi(gv[2]) * wg1[1]; ag[6] += bf_lo(gv[3]) * wg1[2]; ag[7] += bf_hi(gv[3]) * wg1[3];
    au[0] += bf_lo(uv[0]) * wu0[0]; au[1] += bf_hi(uv[0]) * wu0[1]; au[2] += bf_lo(uv[1]) * wu0[2]; au[3] += bf_hi(uv[1]) * wu0[3];
    au[4] += bf_lo(uv[2]) * wu1[0]; au[5] += bf_hi(uv[2]) * wu1[1]; au[6] += bf_lo(uv[3]) * wu1[2]; au[7] += bf_hi(uv[3]) * wu1[3];
}
template <bool GRID>
__device__ __forceinline__ void phase_conv(const Args& a, LAS unsigned char* L, const bf16_t* U, bf16_t* Aff) {
    constexpr int NR = GRID ? 3 : 1, NT = GRID ? 9 : 3, NPJ = GRID ? 13 : 5, TOT = NR * 66 * 32;
    constexpr int ROWB = 66 * 512, OFF_W = NR * ROWB;
    const float* cw = a.in[18]; const float* cbias = a.in[19];
    const int tid0 = threadIdx.x;
    u32x4 R[NPJ], W[2];
    int it = blockIdx.x;
#pragma unroll 1
    for (; it < 128 * 22; it += gridDim.x) {
        int tid = tid0; asm volatile("" : "+v"(tid));
        const int cgl = tid & 15, tp = tid >> 4;
        conv_load<GRID>(R, W, U, cw, cbias, it, tid);
        __syncthreads();
#pragma unroll
        for (int j = 0; j < NPJ; ++j) { const int p = tid + 512 * j; if (p < TOT) *(LAS u32x4*)(L + p * 16) = R[j]; }
#pragma unroll
        for (int j = 0; j < 2; ++j) { const int p = tid + 512 * j; if (p < NT * 64 + 64) *(LAS u32x4*)(L + OFF_W + p * 16) = W[j]; }
        const int span = it / 22, cb = it % 22;
        __syncthreads();
        float ag[2][8], au[2][8];
        { const LAS float* bl = (const LAS float*)(L + OFF_W + NT * 1024);
          const f32x4 g0 = *(const LAS f32x4*)(bl + cgl * 8), g1 = *(const LAS f32x4*)(bl + cgl * 8 + 4), u0 = *(const LAS f32x4*)(bl + 128 + cgl * 8), u1 = *(const LAS f32x4*)(bl + 128 + cgl * 8 + 4);
#pragma unroll
          for (int t = 0; t < 2; ++t)
#pragma unroll
              for (int e = 0; e < 4; ++e) { ag[t][e] = g0[e]; ag[t][4 + e] = g1[e]; au[t][e] = u0[e]; au[t][4 + e] = u1[e]; } }
#pragma unroll 1
        for (int rr = 0; rr < NR; ++rr) {
#pragma unroll
            for (int cs = 0; cs < 4; ++cs) {
                const LAS unsigned char* tp_ = L + rr * ROWB + (2 * tp + cs) * 512 + cgl * 16;
                const u32x4 gv = *(const LAS u32x4*)tp_, uv = *(const LAS u32x4*)(tp_ + 256);
                if (cs <= 2) conv_fma(ag[0], au[0], gv, uv, (const LAS float*)(L + OFF_W) + (rr * 3 + cs) * 256 + cgl * 8);
                if (cs >= 1) conv_fma(ag[1], au[1], gv, uv, (const LAS float*)(L + OFF_W) + (rr * 3 + cs - 1) * 256 + cgl * 8);
            }
        }
#pragma unroll
        for (int t = 0; t < 2; ++t) {
            u32x4 o;
            o.x = cvtpk(silu_f(ag[t][0]) * au[t][0], silu_f(ag[t][1]) * au[t][1]); o.y = cvtpk(silu_f(ag[t][2]) * au[t][2], silu_f(ag[t][3]) * au[t][3]);
            o.z = cvtpk(silu_f(ag[t][4]) * au[t][4], silu_f(ag[t][5]) * au[t][5]); o.w = cvtpk(silu_f(ag[t][6]) * au[t][6], silu_f(ag[t][7]) * au[t][7]);
            *(u32x4*)(Aff + (size_t)(span * 64 + 2 * tp + t) * FF + cb * 128 + cgl * 8) = o;
        }
    }
}

__device__ __forceinline__ void conv_fma64(float (&ag)[8], float (&au)[8], const float (&g)[8], const float (&u)[8], const LAS float* wg) {
    const f32x4 wg0 = *(const LAS f32x4*)wg, wg1 = *(const LAS f32x4*)(wg + 4), wu0 = *(const LAS f32x4*)(wg + 64), wu1 = *(const LAS f32x4*)(wg + 68);
#pragma unroll
    for (int e = 0; e < 4; ++e) { ag[e] += g[e] * wg0[e]; ag[4 + e] += g[4 + e] * wg1[e]; au[e] += u[e] * wu0[e]; au[4 + e] += u[4 + e] * wu1[e]; }
}
__device__ __forceinline__ void phase_conv_grid4(const Args& a, LAS unsigned char* L, const bf16_t* U, bf16_t* Aff) {
    constexpr int ROWB = 66 * 256, TOT = 6 * 66 * 16, OFF_W = 6 * ROWB, NIT = 32 * 44;
    const float* cw = a.in[18]; const float* cbias = a.in[19];
    const int tid0 = threadIdx.x;
#pragma unroll 1
    for (int it = blockIdx.x; it < NIT; it += gridDim.x) {
        int tid = tid0; asm volatile("" : "+v"(tid));
        const int q4 = it / 44, cb = it % 44, batch = q4 >> 3, r0 = (q4 & 7) * 4;
        u32x4 R[13], W;
        { const bf16_t* ub = U + (size_t)(batch * 2048 + r0 * 64) * FF2 + cb * 64;
#pragma unroll
          for (int j = 0; j < 13; ++j) {
              const int p = tid + 512 * j;
              const int rr = p / 1056, rem = p % 1056, sl = rem >> 4, pc = rem & 15, r = r0 + rr - 1;
              const bool ok = (p < TOT) & (r >= 0) & (r < 32) & (sl >= 1) & (sl <= 64);
              const int off = ok ? ((rr - 1) * 64 + sl - 1) * FF2 + (pc < 8 ? pc * 8 : FF + (pc - 8) * 8) : 0;
              u32x4 v = *(const u32x4*)(ub + (ok ? off : 64 * FF2));
              const unsigned m = ok ? 0xffffffffu : 0u; v.x &= m; v.y &= m; v.z &= m; v.w &= m; R[j] = v; }
          const int p = tid < 320 ? tid : 0; const bool isw = p < 288; const int qq = isw ? p : p - 288;
          const int tap = qq >> 5, g = (qq >> 4) & 1, c4 = qq & 15;
          W = *(const u32x4*)((isw ? cw + (size_t)tap * FF2 : cbias) + g * FF + cb * 64 + c4 * 4); }
        __syncthreads();
#pragma unroll
        for (int j = 0; j < 13; ++j) { const int p = tid + 512 * j; if (p < TOT) *(LAS u32x4*)(L + p * 16) = R[j]; }
        if (tid < 320) *(LAS u32x4*)(L + OFF_W + tid * 16) = W;
        __syncthreads();
        const int cgl = tid & 7, w = tid >> 3;
        float ag[4][8], au[4][8];
        { const LAS float* bl = (const LAS float*)(L + OFF_W + 9 * 512);
          const f32x4 g0 = *(const LAS f32x4*)(bl + cgl * 8), g1 = *(const LAS f32x4*)(bl + cgl * 8 + 4), u0 = *(const LAS f32x4*)(bl + 64 + cgl * 8), u1 = *(const LAS f32x4*)(bl + 64 + cgl * 8 + 4);
#pragma unroll
          for (int t = 0; t < 4; ++t)
#pragma unroll
              for (int e = 0; e < 4; ++e) { ag[t][e] = g0[e]; ag[t][4 + e] = g1[e]; au[t][e] = u0[e]; au[t][4 + e] = u1[e]; } }
#pragma unroll 1
        for (int kw = 0; kw < 3; ++kw) {
#pragma unroll
            for (int rr = 0; rr < 6; ++rr) {
                const LAS unsigned char* tp_ = L + rr * ROWB + (w + kw) * 256 + cgl * 16;
                const u32x4 gv = *(const LAS u32x4*)tp_, uv = *(const LAS u32x4*)(tp_ + 128);
                float g[8], u[8];
#pragma unroll
                for (int e = 0; e < 4; ++e) { g[2 * e] = bf_lo(gv[e]); g[2 * e + 1] = bf_hi(gv[e]); u[2 * e] = bf_lo(uv[e]); u[2 * e + 1] = bf_hi(uv[e]); }
#pragma unroll
                for (int kh = 0; kh < 3; ++kh) { const int ro = rr - kh; if (ro >= 0 && ro <= 3) conv_fma64(ag[ro], au[ro], g, u, (const LAS float*)(L + OFF_W) + (kh * 3 + kw) * 128 + cgl * 8); }
            }
        }
#pragma unroll
        for (int t = 0; t < 4; ++t) {
            u32x4 o;
            o.x = cvtpk(silu_f(ag[t][0]) * au[t][0], silu_f(ag[t][1]) * au[t][1]); o.y = cvtpk(silu_f(ag[t][2]) * au[t][2], silu_f(ag[t][3]) * au[t][3]);
            o.z = cvtpk(silu_f(ag[t][4]) * au[t][4], silu_f(ag[t][5]) * au[t][5]); o.w = cvtpk(silu_f(ag[t][6]) * au[t][6], silu_f(ag[t][7]) * au[t][7]);
            *(u32x4*)(Aff + (size_t)(batch * 2048 + (r0 + t) * 64 + w) * FF + cb * 64 + cgl * 8) = o;
        }
    }
}

__device__ __forceinline__ void conv_seq_load(u32x4 (&R)[8], u32x4& W, const bf16_t* U, const float* cw, const float* cbias, int it, int tid) {
    const int b = it / 44, cb = it % 44;
        { const bf16_t* ub = U + (size_t)b * 256 * FF2 + cb * 64;
#pragma unroll
          for (int j = 0; j < 8; ++j) { const int p = tid + 512 * j, t = p >> 4, pc = p & 15; R[j] = *(const u32x4*)(ub + (size_t)t * FF2 + (pc < 8 ? pc * 8 : FF + (pc - 8) * 8)); }
          const int p = tid < 128 ? tid : 0; const bool isw = p < 96; const int qq = isw ? p : p - 96;
          const int tap = qq >> 5, g = (qq >> 4) & 1, c4 = qq & 15;
          W = *(const u32x4*)((isw ? cw + (size_t)tap * FF2 : cbias) + g * FF + cb * 64 + c4 * 4); }
}
__device__ __forceinline__ void phase_conv_seq(const Args& a, LAS unsigned char* L, const bf16_t* U, bf16_t* Aff) {
    constexpr int OFF_W = 258 * 256, NIT = 32 * 44;
    const float* cw = a.in[18] + 3 * FF2; const float* cbias = a.in[19];
    const int tid0 = threadIdx.x;
    __syncthreads();
    if (tid0 < 32) { const int side = tid0 >> 4, pc = tid0 & 15; *(LAS u32x4*)(L + (side ? 257 : 0) * 256 + pc * 16) = (u32x4){0u, 0u, 0u, 0u}; }
    u32x4 R[8], W;
    if ((int)blockIdx.x < NIT) conv_seq_load(R, W, U, cw, cbias, blockIdx.x, tid0);
#pragma unroll 1
    for (int it = blockIdx.x; it < NIT; it += gridDim.x) {
        int tid = tid0; asm volatile("" : "+v"(tid));
        const int b = it / 44, cb = it % 44;
        __syncthreads();
#pragma unroll
        for (int j = 0; j < 8; ++j) { const int p = tid + 512 * j; *(LAS u32x4*)(L + 256 + p * 16) = R[j]; }
        if (tid < 128) *(LAS u32x4*)(L + OFF_W + tid * 16) = W;
        if (it + (int)gridDim.x < NIT) conv_seq_load(R, W, U, cw, cbias, it + gridDim.x, tid);
        __syncthreads();
        const int cgl = tid & 7, tq = tid >> 3;
        float ag[4][8], au[4][8];
        { const LAS float* bl = (const LAS float*)(L + OFF_W + 3 * 512);
          const f32x4 g0 = *(const LAS f32x4*)(bl + cgl * 8), g1 = *(const LAS f32x4*)(bl + cgl * 8 + 4), u0 = *(const LAS f32x4*)(bl + 64 + cgl * 8), u1 = *(const LAS f32x4*)(bl + 64 + cgl * 8 + 4);
#pragma unroll
          for (int t = 0; t < 4; ++t)
#pragma unroll
              for (int e = 0; e < 4; ++e) { ag[t][e] = g0[e]; ag[t][4 + e] = g1[e]; au[t][e] = u0[e]; au[t][4 + e] = u1[e]; } }
#pragma unroll
        for (int cs = 0; cs < 6; ++cs) {
            const LAS unsigned char* tp_ = L + (4 * tq + cs) * 256 + cgl * 16;
            const u32x4 gv = *(const LAS u32x4*)tp_, uv = *(const LAS u32x4*)(tp_ + 128);
            float g[8], u[8];
#pragma unroll
            for (int e = 0; e < 4; ++e) { g[2 * e] = bf_lo(gv[e]); g[2 * e + 1] = bf_hi(gv[e]); u[2 * e] = bf_lo(uv[e]); u[2 * e + 1] = bf_hi(uv[e]); }
#pragma unroll
            for (int t = 0; t < 4; ++t) { const int kw = cs - t; if (kw >= 0 && kw <= 2) conv_fma64(ag[t], au[t], g, u, (const LAS float*)(L + OFF_W) + kw * 128 + cgl * 8); }
        }
#pragma unroll
        for (int t = 0; t < 4; ++t) {
            u32x4 o;
            o.x = cvtpk(silu_f(ag[t][0]) * au[t][0], silu_f(ag[t][1]) * au[t][1]); o.y = cvtpk(silu_f(ag[t][2]) * au[t][2], silu_f(ag[t][3]) * au[t][3]);
            o.z = cvtpk(silu_f(ag[t][4]) * au[t][4], silu_f(ag[t][5]) * au[t][5]); o.w = cvtpk(silu_f(ag[t][6]) * au[t][6], silu_f(ag[t][7]) * au[t][7]);
            *(u32x4*)(Aff + (size_t)(b * 256 + 4 * tq + t) * FF + cb * 64 + cgl * 8) = o;
        }
    }
}

#define XB_TMO      128
#define XB_XCNT(j)  (256  + 64 * (j))
#define XB_XSUB(j)  (1280 + 64 * (j))
#define XB_XGEN(j)  (2304 + 64 * (j))
#define XB_TOP      3328
#define XB_TOPGEN   3392
#define XCD_BAR_WORDS 3456
#define XB_SPIN_CAP (1u << 18)

__device__ __forceinline__ unsigned xb_ld(unsigned* p)              { return __hip_atomic_load(p, __ATOMIC_RELAXED, __HIP_MEMORY_SCOPE_AGENT); }
__device__ __forceinline__ unsigned xb_add(unsigned* p, unsigned v) { return __hip_atomic_fetch_add(p, v, __ATOMIC_RELAXED, __HIP_MEMORY_SCOPE_AGENT); }
__device__ __forceinline__ unsigned xb_xcc_id() { return (unsigned)__builtin_amdgcn_s_getreg((3 << 11) | 20) & 0xFu; }
#define XB_SPIN(cond, bar) do { unsigned _sp = 0; while (cond) { __builtin_amdgcn_s_sleep(1); \
    if ((++_sp & 255u) == 0u) { if (xb_ld(&(bar)[XB_TMO])) break; if (_sp > XB_SPIN_CAP) { atomicAdd(&(bar)[XB_TMO], 1u); break; } } } } while (0)

struct XcdBarrier {
    unsigned* bar; unsigned x;
    volatile LAS unsigned* st;
};

__device__ __forceinline__ XcdBarrier xcd_barrier_post(unsigned* bar, volatile LAS unsigned* st) {
    XcdBarrier b; b.bar = bar; b.x = xb_xcc_id(); b.st = st;
    if (threadIdx.x == 0) (void)xb_add(&bar[XB_XCNT(b.x)], 1u);
    return b;
}
__device__ __forceinline__ void xcd_barrier_complete(unsigned* bar, unsigned x, unsigned& nloc, unsigned& nx) {
    const unsigned G = gridDim.x * gridDim.y * gridDim.z;
    unsigned sum, cnt, mine, sp = 0u;
    for (;;) {
        sum = 0u; cnt = 0u; mine = 0u;
#pragma unroll
        for (unsigned j = 0; j < 16; ++j) { const unsigned c = xb_ld(&bar[XB_XCNT(j)]); sum += c; cnt += (c > 0u) ? 1u : 0u; mine = (j == x) ? c : mine; }
        if (sum == G) break;
        __builtin_amdgcn_s_sleep(1);
        if ((++sp & 255u) == 0u) { if (xb_ld(&bar[XB_TMO])) break; if (sp > XB_SPIN_CAP) { atomicAdd(&bar[XB_TMO], 1u); break; } }
    }
    nloc = mine > 0u ? mine : 1u; nx = cnt > 0u ? cnt : 1u;
}

__device__ __forceinline__ void xcd_barrier(const XcdBarrier& b) {
    asm volatile("s_waitcnt vmcnt(0)" ::: "memory");
    __syncthreads();
    if (threadIdx.x == 0) {
        unsigned* bar = b.bar;
        __builtin_amdgcn_s_waitcnt(0);
        unsigned nloc = b.st[0], nx = b.st[1];
        if (nloc == 0u) { xcd_barrier_complete(bar, b.x, nloc, nx); b.st[0] = nloc; b.st[1] = nx; }
        const unsigned old = xb_add(&bar[XB_XSUB(b.x)], 1u);
        const unsigned gen = old / nloc;
        if (old + 1u == (gen + 1u) * nloc) {
            __builtin_amdgcn_fence(__ATOMIC_RELEASE, "agent");
            asm volatile("s_waitcnt vmcnt(0)" ::: "memory");
            const unsigned og = xb_add(&bar[XB_TOP], 1u);
            const unsigned tg = og / nx;
            if (og + 1u == (tg + 1u) * nx) xb_add(&bar[XB_TOPGEN], 1u);
            else XB_SPIN(xb_ld(&bar[XB_TOPGEN]) == tg, bar);
            __builtin_amdgcn_fence(__ATOMIC_ACQUIRE, "agent");
            xb_add(&bar[XB_XGEN(b.x)], 1u);
            asm volatile("s_waitcnt vmcnt(0)" ::: "memory");
        } else {
            XB_SPIN(xb_ld(&bar[XB_XGEN(b.x)]) == gen, bar);
            __builtin_amdgcn_fence(__ATOMIC_ACQUIRE, "agent");
            asm volatile("s_waitcnt vmcnt(0)" ::: "memory");
        }
    }
    __syncthreads();
}

__device__ __forceinline__ Args load_args() {
    Args r{};
#if defined(__HIP_DEVICE_COMPILE__)
    typedef __attribute__((address_space(4))) const Args* CArgs;
    CArgs q = (CArgs)__builtin_amdgcn_kernarg_segment_ptr(); asm volatile("" : "+s"(q));
#pragma unroll
    for (int i = 0; i < 22; ++i) r.in[i] = q->in[i];
    r.out = q->out; r.ws = q->ws; r.ph_lo = q->ph_lo; r.ph_hi = q->ph_hi;
#endif
    return r;
}
__global__ void __launch_bounds__(512, 2) fwd_mega(Args a_unused) {
    extern __shared__ __attribute__((aligned(16))) unsigned char lds_raw[];
    LAS unsigned char* L = (LAS unsigned char*)lds_raw;
    cg::grid_group grid = cg::this_grid();
    int lo, hi; unsigned* barw; { const Args a0 = load_args(); lo = a0.ph_lo; hi = a0.ph_hi; barw = (unsigned*)(a0.ws + WS_BAR); }
    if (threadIdx.x < 2) ((volatile LAS unsigned*)(L + LDS_MISC))[threadIdx.x] = 0u;
    __syncthreads();
    const XcdBarrier bar = xcd_barrier_post(barw, (volatile LAS unsigned*)(L + LDS_MISC));
    if (hi > 1000) grid.sync();
#define PHASE_VARS const Args a = load_args(); unsigned char* ws = a.ws; bf16_t* XN = (bf16_t*)(ws + WS_XN); const float* mod = (const float*)(ws + WS_MOD); (void)XN; (void)mod;
#define IN(k) (lo <= (k) && (k) < hi)
#define SEAM(k) do { if (IN(k) && IN((k) + 1)) xcd_barrier(bar); } while (0)
    if (IN(0)) { PHASE_VARS phase_prep(a, L); } SEAM(0);
    if (IN(1)) { PHASE_VARS phase_norm1(a, L, XN); } SEAM(1);
    if (IN(2)) { PHASE_VARS pg8::Gemm g{XN, (const bf16_t*)(ws + WS_WIN), MTOK, NP, D}; pg8::StaticOrder S; S.init(MTOK, NP, gridDim.x, blockIdx.x);
        pg8::EpiProj E{(bf16_t*)(ws + WS_P), (const float*)(ws + WS_C0), (const float*)(ws + WS_C1)};
        pg8::gemm_phase<pg8::EpiProj, pg8::StaticOrder, true, true>(L, g, S, E);
        if (gridDim.x == 256 && blockIdx.x >= 128) phase_prep_late(a, L, 128); else if (gridDim.x != 256) phase_prep_late(a, L, 0); } SEAM(2);
    if (IN(3)) { PHASE_VARS phase_scan_light(a, L); } SEAM(3);
    if (IN(4)) { PHASE_VARS phase_scan(a, L); } SEAM(4);
    if (IN(5)) { PHASE_VARS pg8::Gemm g{XN, (const bf16_t*)(ws + WS_WO), MTOK, D, D}; pg8::StaticOrder S; S.init(MTOK, D, gridDim.x, blockIdx.x);
        pg8::EpiResNorm<false> E{a.in[0], a.in[1], a.out, mod, 2048, 3072, 4096, a.in[9], XN, (float*)(ws + WS_SLOTS), (unsigned*)(ws + WS_CNT)};
        pg8::gemm_phase<pg8::EpiResNorm<false>, pg8::StaticOrder, true, true>(L, g, S, E); } SEAM(5);
    if (IN(6)) { PHASE_VARS pg8::Gemm g{XN, (const bf16_t*)(ws + WS_WUP), MP, FF2, D}; pg8::StaticOrder S; S.init(MP, FF2, gridDim.x, blockIdx.x);
        pg8::EpiPlain E{(bf16_t*)(ws + WS_U), FF2};
        pg8::gemm_phase<pg8::EpiPlain, pg8::StaticOrder, true, true>(L, g, S, E); } SEAM(6);
    if (IN(7)) { PHASE_VARS phase_conv_seq(a, L, (const bf16_t*)(ws + WS_U), (bf16_t*)(ws + WS_AFF)); } SEAM(7);
    if (IN(8)) { PHASE_VARS pg8::Gemm g{XN + (size_t)MP * D, (const bf16_t*)(ws + WS_WUP), MP, FF2, D}; pg8::StaticOrder S; S.init(MP, FF2, gridDim.x, blockIdx.x);
        pg8::EpiPlain E{(bf16_t*)(ws + WS_U), FF2};
        pg8::gemm_phase<pg8::EpiPlain, pg8::StaticOrder, true, true>(L, g, S, E); } SEAM(8);
    if (IN(9)) { PHASE_VARS phase_conv_grid4(a, L, (const bf16_t*)(ws + WS_U), (bf16_t*)(ws + WS_AFF) + (size_t)MP * FF); } SEAM(9);
    if (IN(10)) { PHASE_VARS pg8::Gemm g{(const bf16_t*)(ws + WS_AFF), (const bf16_t*)(ws + WS_WDN), MTOK, D, FF}; pg8::StaticOrder S; S.init(MTOK, D, gridDim.x, blockIdx.x);
        pg8::EpiResNorm<true> E{a.out, a.out + (size_t)MP * D, a.out, mod, 5120, 0, 0, a.in[21], nullptr, (float*)(ws + WS_SLOTS) + (size_t)MTOK * 4, (unsigned*)(ws + WS_CNT) + 64 * 64};
        pg8::gemm_phase<pg8::EpiResNorm<true>, pg8::StaticOrder, true, true>(L, g, S, E); } SEAM(10);
#undef IN
#undef SEAM
}

extern "C" void kernel_launch(void* const* d_in, const int* in_sizes, int n_in, void* d_out, int out_size, void* d_ws, size_t ws_size, hipStream_t stream) {
    static int grid = 0;
    if (grid == 0) {
        if (n_in != 22 || ws_size < WS_END) { fprintf(stderr, "kernel_launch: unexpected n_in %d / ws %zu\n", n_in, ws_size); grid = -1; return; }
        int dev = 0, cus = 0, per_cu = 0;
        (void)hipGetDevice(&dev); (void)hipDeviceGetAttribute(&cus, hipDeviceAttributeMultiprocessorCount, dev);
        if (hipFuncSetAttribute((const void*)fwd_mega, hipFuncAttributeMaxDynamicSharedMemorySize, LDS_BYTES) != hipSuccess) { fprintf(stderr, "hipFuncSetAttribute failed\n"); grid = -1; return; }
        if (hipOccupancyMaxActiveBlocksPerMultiprocessor(&per_cu, (const void*)fwd_mega, 512, LDS_BYTES) != hipSuccess || per_cu < 1) { fprintf(stderr, "occupancy query: %d\n", per_cu); grid = -1; return; }
        grid = cus;
        if (grid != 256) { fprintf(stderr, "kernel_launch: built for a 256-CU device (grid %d)\n", grid); grid = -1; return; }
    }
    if (grid < 0) return;
    if (hipMemsetAsync((char*)d_ws + WS_BAR, 0, 16384, stream) != hipSuccess) { fprintf(stderr, "kernel_launch: hipMemsetAsync failed\n"); return; }
    Args a{};
    for (int i = 0; i < 22; ++i) a.in[i] = (const float*)d_in[i];
    a.out = (float*)d_out; a.ws = (unsigned char*)d_ws;
#if MK_MULTI
    for (int p = 0; p < NPH; ++p) { a.ph_lo = p; a.ph_hi = p + 1; hipLaunchKernelGGL(fwd_mega, dim3(grid), dim3(512), LDS_BYTES, stream, a); }
#else
    a.ph_lo = 0; a.ph_hi = NPH;
    void* args[] = {&a};
    hipError_t e = hipLaunchCooperativeKernel((const void*)fwd_mega, dim3(grid), dim3(512), args, LDS_BYTES, stream);
    if (e != hipSuccess) fprintf(stderr, "cooperative launch failed: %s (grid %d)\n", hipGetErrorString(e), grid);
#endif
}
```

```cpp
#include <hip/hip_runtime.h>
#include <hip/hip_cooperative_groups.h>
#include <cstdio>
#include <cstdint>
namespace cg = cooperative_groups;
#ifndef MK_MULTI
#define MK_MULTI 0
#endif
namespace pg8 {
#define PG8_LAS __attribute__((address_space(3)))
typedef unsigned short bf16_t;
typedef short bf16x8 __attribute__((ext_vector_type(8)));
typedef float f32x4 __attribute__((ext_vector_type(4)));
typedef unsigned u32x4 __attribute__((ext_vector_type(4)));
typedef unsigned u32x2 __attribute__((ext_vector_type(2)));
constexpr int BM = 256, BK = 64, HALF = 128, HTB = HALF * BK * 2  , STAGE_BYTES = 8 * HTB, NXCD = 8, WGM = 8;

__host__ __device__ __forceinline__ int lds_byte(int r, int c) { const int st = (r >> 4) * 2 + (c >> 5), rr = r & 15, cc = c & 31, ob = rr * 64 + cc * 2; return st * 1024 + (ob ^ (((ob >> 9) & 1) << 5)); }
__host__ __device__ __forceinline__ void stage_rc(int b, int& R, int& C) { const int st = b / 1024, sb = b % 1024, swz = sb ^ (((sb >> 9) & 1) << 5); R = (st >> 1) * 16 + swz / 64; C = (st & 1) * 32 + (swz % 64) / 2; }
__host__ __device__ __forceinline__ int perm32(int rho) { const int n = rho >> 4, i = rho & 15; return 8 * (i >> 2) + 4 * n + (i & 3); }

struct Unit { int pm, pn; };
struct Gemm { const bf16_t* A; const bf16_t* Bt; int M, N, K; };

struct StaticOrder {
    int nM, nN, nwg, G, c;
    __host__ __device__ void init(int M, int N, int G_, int c_) { nM = M / BM; nN = N / BM; nwg = nM * nN; G = G_; c = c_; }
    __host__ __device__ bool next(int i, Unit& u) const {
        const long L = (long)i * G + c; if (L >= nwg) return false;
        int wgid = (int)L; { const int q = nwg / NXCD, r = nwg % NXCD, xcd = wgid % NXCD, off = wgid / NXCD; wgid = (xcd < r ? xcd * (q + 1) : r * (q + 1) + (xcd - r) * q) + off; }
        const int nig = WGM * nN, gid = wgid / nig, fm = gid * WGM, gsz = (nM - fm) < WGM ? (nM - fm) : WGM;
        u.pm = fm + ((wgid % nig) % gsz); u.pn = (wgid % nig) / gsz; return true;
    }
    __device__ __forceinline__ void a_ready(const Unit&) const {}
    __device__ __forceinline__ void done(const Unit&) const {}
};

__device__ __forceinline__ unsigned cvt_pk_bf16(float lo, float hi) { unsigned r; asm volatile("v_cvt_pk_bf16_f32 %0, %1, %2" : "=v"(r) : "v"(lo), "v"(hi)); return r; }
typedef float f32x2 __attribute__((ext_vector_type(2)));
typedef float f32x2_t __attribute__((ext_vector_type(2))); typedef __bf16 bf16x2_t __attribute__((ext_vector_type(2)));
__device__ __forceinline__ unsigned cvtpk(float lo, float hi) { f32x2_t v = {lo, hi}; bf16x2_t b = __builtin_convertvector(v, bf16x2_t); return __builtin_bit_cast(unsigned, b); }
__device__ __forceinline__ float fast_exp(float x) { return __builtin_amdgcn_exp2f(x * 1.4426950408889634f); }
__device__ __forceinline__ float fast_log(float x) { return __builtin_amdgcn_logf(x) * 0.6931471805599453f; }
__device__ __forceinline__ float fast_rcp(float x) { return __builtin_amdgcn_rcpf(x); }
__device__ __forceinline__ float silu_f(float x) { return x * fast_rcp(1.f + fast_exp(-x)); }

struct EpiPlain {
    static constexpr bool PERM = true, AFTER_DRAIN = false;
    bf16_t* O; int ldc;
    __device__ __forceinline__ void operator()(const f32x4 (&acc)[2][2][4][2], const Unit& u, int wr, int wc, int fr, int fq) const {
        const int row0 = u.pm * BM + wr * 64 + fr, col0 = u.pn * BM + wc * 32 + 8 * fq;
#pragma unroll
        for (int ai = 0; ai < 2; ++ai)
#pragma unroll
            for (int m = 0; m < 4; ++m) { bf16_t* rowp = O + (size_t)(row0 + ai * HALF + m * 16) * ldc + col0;
#pragma unroll
                for (int bj = 0; bj < 2; ++bj) { const f32x4 v0 = acc[ai][bj][m][0], v1 = acc[ai][bj][m][1];
                    u32x4 w; w.x = cvtpk(v0[0], v0[1]); w.y = cvtpk(v0[2], v0[3]); w.z = cvtpk(v1[0], v1[1]); w.w = cvtpk(v1[2], v1[3]);
                    *(u32x4*)(rowp + bj * HALF) = w; } }
    }
};
struct EpiProj {
    static constexpr bool PERM = true, AFTER_DRAIN = false;
    bf16_t* O; const float* c0; const float* c1;
    __device__ __forceinline__ void operator()(const f32x4 (&acc)[2][2][4][2], const Unit& u, int wr, int wc, int fr, int fq) const {
        const int row0 = u.pm * BM + wr * 64 + fr; const int pn = u.pn;
        const int kind = (pn == 0) ? 1 : ((pn == 4 || pn == 5 || pn == 14 || pn == 15) ? 2 : ((pn >= 8 && pn <= 11) ? 3 : (pn >= 16 ? 4 : 0)));
#pragma unroll
        for (int bj = 0; bj < 2; ++bj) {
            const int col = pn * BM + bj * HALF + wc * 32 + 8 * fq;
            f32x4 ca0 = {0.f, 0.f, 0.f, 0.f}, ca1 = ca0, cb0 = ca0, cb1 = ca0;
            if (kind >= 3) { ca0 = *(const f32x4*)(c0 + col); ca1 = *(const f32x4*)(c0 + col + 4); }
            if (kind == 3) { cb0 = *(const f32x4*)(c1 + col); cb1 = *(const f32x4*)(c1 + col + 4); }
#pragma unroll
            for (int ai = 0; ai < 2; ++ai)
#pragma unroll
                for (int m = 0; m < 4; ++m) {
                    f32x4 v0 = acc[ai][bj][m][0], v1 = acc[ai][bj][m][1];
                    if (kind == 1) { v0 = v0 * 0.125f; v1 = v1 * 0.125f; }
                    else if (kind == 2) {
#pragma unroll
                        for (int e = 0; e < 4; ++e) { v0[e] = silu_f(v0[e]); v1[e] = silu_f(v1[e]); } }
                    else if (kind == 3) {
#pragma unroll
                        for (int e = 0; e < 4; ++e) { v0[e] = fast_log(ca0[e] + cb0[e] * fast_rcp(1.f + fast_exp(-v0[e]))); v1[e] = fast_log(ca1[e] + cb1[e] * fast_rcp(1.f + fast_exp(-v1[e]))); } }
                    else if (kind == 4) {
#pragma unroll
                        for (int e = 0; e < 4; ++e) { v0[e] = -0.0625f * fast_log(1.f + fast_exp(-(v0[e] + ca0[e]))); v1[e] = -0.0625f * fast_log(1.f + fast_exp(-(v1[e] + ca1[e]))); } }
                    u32x4 w; w.x = cvtpk(v0[0], v0[1]); w.y = cvtpk(v0[2], v0[3]); w.z = cvtpk(v1[0], v1[1]); w.w = cvtpk(v1[2], v1[3]);
                    *(u32x4*)(O + (size_t)(row0 + ai * HALF + m * 16) * 4608 + col) = w;
                }
        }
    }
};
struct EpiRes {
    static constexpr bool PERM = false, AFTER_DRAIN = false;
    const float* base0; const float* base1; float* out; const float* gate;
    __device__ __forceinline__ void operator()(const f32x4 (&acc)[2][2][4][2], const Unit& u, int wr, int wc, int fr, int fq) const {
        const int rt = u.pm * BM;
        const float* base = rt < 8192 ? base0 + (size_t)rt * 1024 : base1 + (size_t)(rt - 8192) * 1024;
        const float* g = gate + (rt < 8192 ? 0 : 1 + ((rt - 8192) >> 11)) * 6144;
        float* o = out + (size_t)rt * 1024;
        const int col0 = u.pn * BM + wc * 32 + 4 * fq;
#pragma unroll
        for (int bj = 0; bj < 2; ++bj)
#pragma unroll
            for (int n = 0; n < 2; ++n) { const int col = col0 + bj * HALF + n * 16; const f32x4 g4 = *(const f32x4*)(g + col);
#pragma unroll
                for (int ai = 0; ai < 2; ++ai)
#pragma unroll
                    for (int m = 0; m < 4; ++m) { const size_t off = (size_t)(ai * HALF + wr * 64 + m * 16 + fr) * 1024 + col;
                        const f32x4 b = *(const f32x4*)(base + off); *(f32x4*)(o + off) = b + g4 * acc[ai][bj][m][n]; } }
    }
};

template <bool FINAL> struct EpiResNorm {
    static constexpr bool PERM = false, AFTER_DRAIN = true;
    static constexpr int LROW = 260;
    const float* base0; const float* base1; float* out; const float* mod; int gate_off, shift_off, scale_off; const float* gvec; bf16_t* XN; float* slots; unsigned* cnt;
    __device__ __forceinline__ void fused(f32x4 (&acc)[2][2][4][2], const Unit& u, int wr, int wc, int fr, int fq, PG8_LAS unsigned char* lds, int wid, int lane) const {
        const int rt = u.pm * BM;
        const float* base = rt < 8192 ? base0 + (size_t)rt * 1024 : base1 + (size_t)(rt - 8192) * 1024;
        const float* mv = mod + (rt < 8192 ? 0 : 1 + ((rt - 8192) >> 11)) * 6144;
        float* o = out + (size_t)rt * 1024;
        const int col0 = u.pn * BM + wc * 32 + 4 * fq;
        PG8_LAS float* T = (PG8_LAS float*)lds;
        PG8_LAS float* Pp = T + 128 * LROW; PG8_LAS float* Sr = Pp + 1024;
        const int lbase = (wr * 64 + fr) * LROW + wc * 32 + 4 * fq;
        float ss[2][4];
#pragma unroll
        for (int ai = 0; ai < 2; ++ai)
#pragma unroll
            for (int m = 0; m < 4; ++m) ss[ai][m] = 0.f;
#pragma unroll
        for (int bj = 0; bj < 2; ++bj)
#pragma unroll
            for (int n = 0; n < 2; ++n) { const int col = col0 + bj * HALF + n * 16; const f32x4 g4 = *(const f32x4*)(mv + gate_off + col);
                f32x4 bv[2][4];
#pragma unroll
                for (int ai = 0; ai < 2; ++ai)
#pragma unroll
                    for (int m = 0; m < 4; ++m) bv[ai][m] = *(const f32x4*)(base + (size_t)(ai * HALF + wr * 64 + m * 16 + fr) * 1024 + col);
#pragma unroll
                for (int ai = 0; ai < 2; ++ai)
#pragma unroll
                    for (int m = 0; m < 4; ++m) { const size_t off = (size_t)(ai * HALF + wr * 64 + m * 16 + fr) * 1024 + col;
                        const f32x4 v = bv[ai][m] + g4 * acc[ai][bj][m][n];
                        if (!FINAL) *(f32x4*)(o + off) = v;
                        ss[ai][m] += (v[0] * v[0] + v[1] * v[1]) + (v[2] * v[2] + v[3] * v[3]);
                        if (ai == 0) *(PG8_LAS f32x4*)(T + lbase + m * 16 * LROW + bj * HALF + n * 16) = v; else acc[1][bj][m][n] = v; } }
#pragma unroll
        for (int ai = 0; ai < 2; ++ai)
#pragma unroll
            for (int m = 0; m < 4; ++m) { float s = ss[ai][m]; s += __shfl_xor(s, 16); s += __shfl_xor(s, 32);
                if (fq == 0) Pp[(ai * HALF + wr * 64 + m * 16 + fr) * 4 + wc] = s; }
        __syncthreads();
        const int tid = wid * 64 + lane;
        if (tid < 256) { const f32x4 p = *(const PG8_LAS f32x4*)(Pp + tid * 4);
            __hip_atomic_store(slots + (size_t)(rt + tid) * 4 + u.pn, (p[0] + p[1]) + (p[2] + p[3]), __ATOMIC_RELAXED, __HIP_MEMORY_SCOPE_AGENT); }
        asm volatile("s_waitcnt vmcnt(0)" ::: "memory");
        __syncthreads();
        if (tid == 0) { unsigned* c = cnt + 64 * u.pm; __hip_atomic_fetch_add(c, 1u, __ATOMIC_RELAXED, __HIP_MEMORY_SCOPE_AGENT);
            for (unsigned sp = 0; sp < (1u << 24); ++sp) { if (__hip_atomic_load(c, __ATOMIC_RELAXED, __HIP_MEMORY_SCOPE_AGENT) >= 4u) break; __builtin_amdgcn_s_sleep(1); } }
        __syncthreads();
        if (tid < 256) { float t = 0.f;
#pragma unroll
            for (int q = 0; q < 4; ++q) t += __hip_atomic_load(slots + (size_t)(rt + tid) * 4 + q, __ATOMIC_RELAXED, __HIP_MEMORY_SCOPE_AGENT);
            Sr[tid] = rsqrtf(t * (1.f / 1024.f) + 1e-6f); }
        __syncthreads();
#pragma unroll
        for (int bj = 0; bj < 2; ++bj)
#pragma unroll
            for (int n = 0; n < 2; ++n) { const int col = col0 + bj * HALF + n * 16; const f32x4 gg = *(const f32x4*)(gvec + col);
                f32x4 sc = {0.f, 0.f, 0.f, 0.f}, sh = sc; if (!FINAL) { sc = *(const f32x4*)(mv + scale_off + col) + 1.f; sh = *(const f32x4*)(mv + shift_off + col); }
#pragma unroll
                for (int ai = 0; ai < 2; ++ai)
#pragma unroll
                    for (int m = 0; m < 4; ++m) { const int r = ai * HALF + wr * 64 + m * 16 + fr; const float rs = Sr[r];
                        const f32x4 v = ai == 0 ? *(const PG8_LAS f32x4*)(T + lbase + m * 16 * LROW + bj * HALF + n * 16) : acc[1][bj][m][n];
                        if (FINAL) *(f32x4*)(o + (size_t)r * 1024 + col) = v * rs * gg;
                        else { const f32x4 h = v * rs * gg * sc + sh; u32x2 w; w.x = cvtpk(h[0], h[1]); w.y = cvtpk(h[2], h[3]); *(u32x2*)(XN + (size_t)(rt + r) * 1024 + col) = w; } } }
    }
};
template <class Epi, class Sched, bool ALIGN_EPI = false, bool SP2 = false>
__device__ __forceinline__ void gemm_phase(PG8_LAS unsigned char* lds, const Gemm g, const Sched& S, const Epi& E) {
    const int tid = threadIdx.x, wid = __builtin_amdgcn_readfirstlane(tid >> 6), lane = tid & 63, wr = wid >> 2, wc = wid & 3, fr = lane & 15, fq = lane >> 4;
    const int K = g.K, nt = K / BK;
    unsigned voffA[2], voffB[2];
#pragma unroll
    for (int i = 0; i < 2; ++i) { int R, C; stage_rc(tid * 16 + i * 8192, R, C); const int Rb = Epi::PERM ? ((R & ~31) + perm32(R & 31)) : R;
        voffA[i] = (unsigned)(R * K + C) * 2u; voffB[i] = (unsigned)(Rb * K + C) * 2u; }
    const size_t kstep = (size_t)(BK * 2);
    const size_t hstep = (size_t)HALF * K * 2;
    const size_t tstep = 2 * hstep;
    const unsigned ldsw = (unsigned)wid * 1024u;
    const int aoff = lds_byte(wr * 64 + fr, fq * 8), boff = lds_byte(wc * 32 + fr, fq * 8);
#define PG8_SA(b, h) (((b) * 2 + (h)) * HTB)
#define PG8_SB(b, h) ((4 + (b) * 2 + (h)) * HTB)
#define PG8_STAGE(bufoff, gbase, voff) do { _Pragma("unroll") for (int _i = 0; _i < 2; ++_i) \
        __builtin_amdgcn_global_load_lds((const unsigned*)((const char*)(gbase) + (voff)[_i]), (PG8_LAS unsigned*)(lds + (bufoff) + ldsw + _i * 8192), 16, 0, 0); } while (0)
#define PG8_LDA(dst, b, h) do { _Pragma("unroll") for (int m = 0; m < 4; ++m) _Pragma("unroll") for (int k = 0; k < 2; ++k) dst[m][k] = *(const PG8_LAS bf16x8*)(lds + PG8_SA(b, h) + aoff + m * 2048 + k * 1024); } while (0)
#define PG8_LDB(dst, b, h) do { _Pragma("unroll") for (int n = 0; n < 2; ++n) _Pragma("unroll") for (int k = 0; k < 2; ++k) dst[n][k] = *(const PG8_LAS bf16x8*)(lds + PG8_SB(b, h) + boff + n * 2048 + k * 1024); } while (0)
#define PG8_MMA(ai, bj, At, Bt) do { __builtin_amdgcn_s_setprio(1); _Pragma("unroll") for (int m = 0; m < 4; ++m) _Pragma("unroll") for (int n = 0; n < 2; ++n) _Pragma("unroll") for (int k = 0; k < 2; ++k) \
        acc[ai][bj][m][n] = __builtin_amdgcn_mfma_f32_16x16x32_bf16(Bt[n][k], At[m][k], acc[ai][bj][m][n], 0, 0, 0); __builtin_amdgcn_s_setprio(0); } while (0)
#define PG8_WAIT_V(n) asm volatile("s_waitcnt vmcnt(" #n ")" ::: "memory")
#define PG8_WAIT_L(n) asm volatile("s_waitcnt lgkmcnt(" #n ")" ::: "memory")
#define PG8_BAR __builtin_amdgcn_s_barrier()
#define PG8_SCHED __builtin_amdgcn_sched_barrier(0)
    Unit cur, nxt; int ui = 0;
    if (!S.next(0, cur)) return;
    f32x4 acc[2][2][4][2];
#pragma unroll
    for (int a = 0; a < 2; ++a)
#pragma unroll
        for (int b = 0; b < 2; ++b)
#pragma unroll
            for (int m = 0; m < 4; ++m)
#pragma unroll
                for (int n = 0; n < 2; ++n) acc[a][b][m][n] = (f32x4){0.f, 0.f, 0.f, 0.f};
    bf16x8 At[4][2], B0[2][2], B1[2][2];
    const char* cA = (const char*)g.A + (size_t)cur.pm * tstep; const char* cB = (const char*)g.Bt + (size_t)cur.pn * tstep;
    S.a_ready(cur);
    if constexpr (SP2) {
        PG8_STAGE(PG8_SB(0, 0), cB, voffB); PG8_STAGE(PG8_SB(0, 1), cB + hstep, voffB); PG8_STAGE(PG8_SA(0, 0), cA, voffA); PG8_STAGE(PG8_SA(0, 1), cA + hstep, voffA);
        if (wr == 1) PG8_BAR;
        PG8_WAIT_V(2); PG8_BAR;
        PG8_STAGE(PG8_SB(1, 0), cB + kstep, voffB); PG8_STAGE(PG8_SA(1, 0), cA + kstep, voffA); PG8_STAGE(PG8_SB(1, 1), cB + hstep + kstep, voffB);
        PG8_WAIT_V(6); PG8_BAR;
    } else {
        PG8_STAGE(PG8_SB(0, 0), cB, voffB); PG8_STAGE(PG8_SA(0, 0), cA, voffA); PG8_STAGE(PG8_SB(0, 1), cB + hstep, voffB); PG8_STAGE(PG8_SA(0, 1), cA + hstep, voffA);
        if (wr == 1) PG8_BAR;
        PG8_WAIT_V(4); PG8_BAR;
        PG8_STAGE(PG8_SB(1, 0), cB + kstep, voffB); PG8_STAGE(PG8_SA(1, 0), cA + kstep, voffA); PG8_STAGE(PG8_SB(1, 1), cB + hstep + kstep, voffB);
        PG8_WAIT_V(6); PG8_BAR;
    }
    for (;;) {
        const bool has_next = S.next(ui + 1, nxt);
        const char* nA = has_next ? (const char*)g.A + (size_t)nxt.pm * tstep : cA; const char* nB = has_next ? (const char*)g.Bt + (size_t)nxt.pn * tstep : cB;
        for (int t = 0; t < nt; t += 2) {
            const bool last = (t == nt - 2);
            const char* a1 = cA + (size_t)(t + 1) * kstep;
            const char* a2 = last ? nA : cA + (size_t)(t + 2) * kstep; const char* b2 = last ? nB : cB + (size_t)(t + 2) * kstep;
            const char* a3 = a2 + kstep; const char* b3 = b2 + kstep;
            if (last && has_next) S.a_ready(nxt);
            if constexpr (SP2) {
            PG8_LDB(B0, 0, 0); PG8_LDB(B1, 0, 1); PG8_SCHED; PG8_LDA(At, 0, 0); PG8_STAGE(PG8_SA(1, 1), a1 + hstep, voffA);
            PG8_WAIT_V(8); PG8_WAIT_L(0); PG8_BAR; PG8_MMA(0, 0, At, B0); PG8_MMA(0, 1, At, B1); PG8_BAR; PG8_SCHED;
            PG8_LDA(At, 0, 1); PG8_STAGE(PG8_SB(0, 0), b2, voffB); PG8_STAGE(PG8_SB(0, 1), b2 + hstep, voffB); PG8_STAGE(PG8_SA(0, 0), a2, voffA);
            PG8_WAIT_V(8); PG8_WAIT_L(0); PG8_BAR; PG8_MMA(1, 0, At, B0); PG8_MMA(1, 1, At, B1); PG8_BAR; PG8_SCHED;
            PG8_LDB(B0, 1, 0); PG8_LDB(B1, 1, 1); PG8_SCHED; PG8_LDA(At, 1, 0); PG8_STAGE(PG8_SA(0, 1), a2 + hstep, voffA);
            PG8_WAIT_V(8); PG8_WAIT_L(0); PG8_BAR; PG8_MMA(0, 0, At, B0); PG8_MMA(0, 1, At, B1); PG8_BAR; PG8_SCHED;
            PG8_LDA(At, 1, 1); PG8_STAGE(PG8_SB(1, 0), b3, voffB); PG8_STAGE(PG8_SB(1, 1), b3 + hstep, voffB); PG8_STAGE(PG8_SA(1, 0), a3, voffA);
            PG8_WAIT_V(8); PG8_WAIT_L(0); PG8_BAR; PG8_MMA(1, 0, At, B0); PG8_MMA(1, 1, At, B1); PG8_BAR; PG8_SCHED;
            } else {
            PG8_LDB(B0, 0, 0); PG8_SCHED; PG8_LDA(At, 0, 0); PG8_STAGE(PG8_SA(1, 1), a1 + hstep, voffA);
            PG8_WAIT_L(8); PG8_BAR; PG8_WAIT_L(0); PG8_MMA(0, 0, At, B0); PG8_BAR; PG8_SCHED;
            PG8_LDB(B1, 0, 1); PG8_STAGE(PG8_SB(0, 0), b2, voffB);
            PG8_BAR; PG8_WAIT_L(0); PG8_MMA(0, 1, At, B1); PG8_BAR;
            PG8_LDA(At, 0, 1); PG8_STAGE(PG8_SA(0, 0), a2, voffA);
            PG8_BAR; PG8_WAIT_L(0); PG8_MMA(1, 0, At, B0); PG8_BAR; PG8_SCHED;
            PG8_STAGE(PG8_SB(0, 1), b2 + hstep, voffB);
            PG8_WAIT_V(6); PG8_BAR; PG8_MMA(1, 1, At, B1); PG8_BAR;
            PG8_LDB(B0, 1, 0); PG8_SCHED; PG8_LDA(At, 1, 0); PG8_STAGE(PG8_SA(0, 1), a2 + hstep, voffA);
            PG8_WAIT_L(8); PG8_BAR; PG8_WAIT_L(0); PG8_MMA(0, 0, At, B0); PG8_BAR; PG8_SCHED;
            PG8_LDB(B1, 1, 1); PG8_STAGE(PG8_SB(1, 0), b3, voffB);
            PG8_BAR; PG8_WAIT_L(0); PG8_MMA(0, 1, At, B1); PG8_BAR;
            PG8_LDA(At, 1, 1); PG8_STAGE(PG8_SA(1, 0), a3, voffA);
            PG8_BAR; PG8_WAIT_L(0); PG8_MMA(1, 0, At, B0); PG8_BAR; PG8_SCHED;
            PG8_STAGE(PG8_SB(1, 1), b3 + hstep, voffB);
            PG8_WAIT_V(6); PG8_BAR; PG8_MMA(1, 1, At, B1); PG8_BAR;
            }
        }
        if constexpr (ALIGN_EPI) { if (wr == 0) PG8_BAR; }
        if constexpr (!Epi::AFTER_DRAIN) { E(acc, cur, wr, wc, fr, fq); S.done(cur); }
        if (!has_next) break;
#pragma unroll
        for (int a = 0; a < 2; ++a)
#pragma unroll
            for (int b = 0; b < 2; ++b)
#pragma unroll
                for (int m = 0; m < 4; ++m)
#pragma unroll
                    for (int n = 0; n < 2; ++n) acc[a][b][m][n] = (f32x4){0.f, 0.f, 0.f, 0.f};
        cur = nxt; cA = nA; cB = nB; ++ui;
        if constexpr (ALIGN_EPI) { if (wr == 1) PG8_BAR; }
    }
    PG8_WAIT_V(0);
    if constexpr (!ALIGN_EPI) { if (wr == 0) PG8_BAR; }
    PG8_BAR;
    if constexpr (Epi::AFTER_DRAIN) { E.fused(acc, cur, wr, wc, fr, fq, lds, wid, lane); S.done(cur); }
#undef PG8_SA
#undef PG8_SB
#undef PG8_STAGE
#undef PG8_LDA
#undef PG8_LDB
#undef PG8_MMA
#undef PG8_WAIT_V
#undef PG8_WAIT_L
#undef PG8_BAR
#undef PG8_SCHED
}
}
#define LAS __attribute__((address_space(3)))
typedef unsigned short bf16_t;
typedef float f32x4 __attribute__((ext_vector_type(4)));
typedef unsigned u32x4 __attribute__((ext_vector_type(4)));
typedef unsigned u32x2 __attribute__((ext_vector_type(2)));
typedef short bf16x8 __attribute__((ext_vector_type(8)));
typedef short s16x4 __attribute__((ext_vector_type(4)));
using pg8::f32x2_t; using pg8::cvtpk; using pg8::fast_exp; using pg8::fast_log; using pg8::fast_rcp; using pg8::silu_f;

constexpr int D = 1024, MTOK = 16384, MP = 8192, NP = 4608, FF = 2816, FF2 = 5632, INW = 4128, NMOD = 6144;
constexpr float EPS = 1e-6f;
constexpr size_t MiB = 1u << 20;
constexpr size_t WS_MOD = 0, WS_C0 = 256 * 1024, WS_C1 = 512 * 1024, WS_PART = 1 * MiB, WS_WIN = 2 * MiB, WS_WO = 11 * MiB, WS_WUP = 13 * MiB, WS_WDN = 24 * MiB,
                 WS_XN = 30 * MiB, WS_P = 62 * MiB, WS_U = 62 * MiB, WS_AFF = 150 * MiB, WS_END = 240 * MiB;
constexpr size_t WS_CNT = 768 * 1024, WS_SLOTS = 239 * MiB;
constexpr size_t WS_BAR = 832 * 1024;
constexpr int LDS_BYTES = 163840, LDS_MISC = 163840 - 64;
constexpr int NPH = 11;

__device__ __forceinline__ float bf_lo(unsigned u) { return __uint_as_float(u << 16); }
__device__ __forceinline__ float bf_hi(unsigned u) { return __uint_as_float(u & 0xffff0000u); }
__device__ __forceinline__ float wave_sum(float v) {
#pragma unroll
    for (int o = 1; o < 64; o <<= 1) v += __shfl_xor(v, o);
    return v;
}

struct Args { const float* in[22]; float* out; unsigned char* ws; int ph_lo, ph_hi; };

__device__ __forceinline__ void tr_store(bf16_t* WT, int K, int dst_row0, int k0, LAS float* scr, int lane) {
    asm volatile("s_waitcnt lgkmcnt(0)" ::: "memory");
    const int c = lane & 7;
#pragma unroll
    for (int j = 0; j < 4; ++j) { const int n = (lane >> 3) + 8 * j; const LAS float* s = scr + (8 * c) * 33 + n;
        u32x4 o; o.x = cvtpk(s[0 * 33], s[1 * 33]); o.y = cvtpk(s[2 * 33], s[3 * 33]); o.z = cvtpk(s[4 * 33], s[5 * 33]); o.w = cvtpk(s[6 * 33], s[7 * 33]);
        *(u32x4*)(WT + (size_t)(dst_row0 + n) * K + k0 + 8 * c) = o; }
    asm volatile("s_waitcnt lgkmcnt(0)" ::: "memory");
}
__device__ __forceinline__ void tr_item(const float* W, int ldw, int src_col0, bf16_t* WT, int K, int dst_row0, int k0, LAS float* scr, int lane) {
#pragma unroll 8
    for (int i = 0; i < 32; ++i) { const int kk = 2 * i + (lane >> 5); scr[kk * 33 + (lane & 31)] = W[(size_t)(k0 + kk) * ldw + src_col0 + (lane & 31)]; }
    tr_store(WT, K, dst_row0, k0, scr, lane);
}
__device__ __forceinline__ void tr_item_alpha(const float* Win, const float* Wup, bf16_t* WT, int nb, int k0, LAS float* scr, int lane) {
    const int n0 = 32 * nb, dir = n0 >> 8, kc = (n0 & 255) + (lane & 31);
    float up[16];
#pragma unroll
    for (int r = 0; r < 16; ++r) up[r] = Wup[(dir * 16 + r) * 256 + kc];
    for (int i = 0; i < 32; ++i) { const int kk = 2 * i + (lane >> 5); const f32x4* wr = (const f32x4*)(Win + (size_t)(k0 + kk) * INW + 1536 + dir * 16);
        float s = 0.f;
#pragma unroll
        for (int q = 0; q < 4; ++q) { const f32x4 w = wr[q]; s += w[0] * up[4 * q] + w[1] * up[4 * q + 1] + w[2] * up[4 * q + 2] + w[3] * up[4 * q + 3]; }
        scr[kk * 33 + (lane & 31)] = s; }
    tr_store(WT, 1024, 4096 + n0, k0, scr, lane);
}

__device__ __forceinline__ void phase_prep(const Args& a, LAS unsigned char* L) {
    const int tid = threadIdx.x, lane = tid & 63, wave = tid >> 6;
    LAS float* scr = (LAS float*)(L + wave * 8704);
    LAS float* sc = (LAS float*)(L + 8 * 8704);
    for (int i = tid; i < 5 * 1024; i += 512) { const int v = i >> 10, k = i & 1023; const float x = v == 0 ? a.in[5][k] : a.in[4][(v - 1) * 1024 + k]; sc[i] = x / (1.f + __expf(-x)); }
    __syncthreads();
    bf16_t* WinT = (bf16_t*)(a.ws + WS_WIN); bf16_t* WoT = (bf16_t*)(a.ws + WS_WO); bf16_t* WupT = (bf16_t*)(a.ws + WS_WUP); bf16_t* WdnT = (bf16_t*)(a.ws + WS_WDN);
    float* part = (float*)(a.ws + WS_PART);
    if (blockIdx.x == 0 && tid < 128) ((unsigned*)(a.ws + WS_CNT))[tid * 64] = 0u;
    const int gw = blockIdx.x * 8 + wave, NGW = gridDim.x * 8;
    constexpr int I_MOD = 96 * 8, I_IN = 16 * 128, I_AL = 16 * 16, I_O = 16 * 32, I_UP = 16 * 176, I_DN = 44 * 32;
    constexpr int NIT = I_MOD + I_IN + I_AL;
    for (int it = gw; it < NIT; it += NGW) {
        int r = it;
        if (r < I_MOD) {
            const int cb = r >> 3, ks = r & 7, col = 64 * cb + lane; const float* w = a.in[6] + (size_t)(128 * ks) * NMOD + col;
            float acc[5] = {0.f, 0.f, 0.f, 0.f, 0.f};
            for (int k = 0; k < 128; k += 16) { float wv[16];
#pragma unroll
                for (int j = 0; j < 16; ++j) wv[j] = w[(size_t)(k + j) * NMOD];
#pragma unroll
                for (int j = 0; j < 16; ++j)
#pragma unroll
                    for (int v = 0; v < 5; ++v) acc[v] += sc[v * 1024 + 128 * ks + k + j] * wv[j]; }
#pragma unroll
            for (int v = 0; v < 5; ++v) part[(size_t)(ks * 5 + v) * NMOD + col] = acc[v];
            continue; }
        r -= I_MOD;
        if (r < I_IN) { const int kb = r >> 7, nb = r & 127, n0 = 32 * nb; tr_item(a.in[10], INW, n0 + (n0 >= 1536 ? 32 : 0), WinT, 1024, n0, 64 * kb, scr, lane); continue; }
        r -= I_IN;
        tr_item_alpha(a.in[10], a.in[11], WinT, r & 15, 64 * (r >> 4), scr, lane);
    }
}
__device__ __forceinline__ void phase_prep_late(const Args& a, LAS unsigned char* L, int nb0) {
    const int tid = threadIdx.x, lane = tid & 63, wave = tid >> 6;
    LAS float* scr = (LAS float*)(L + wave * 8704);
    bf16_t* WoT = (bf16_t*)(a.ws + WS_WO); bf16_t* WupT = (bf16_t*)(a.ws + WS_WUP); bf16_t* WdnT = (bf16_t*)(a.ws + WS_WDN);
    constexpr int I_O = 16 * 32, I_UP = 16 * 176, I_DN = 44 * 32;
    const int gw = ((int)blockIdx.x - nb0) * 8 + wave, NGW = ((int)gridDim.x - nb0) * 8;
    for (int it = gw; it < I_O + I_UP + I_DN; it += NGW) {
        int r = it;
        if (r < I_O) { tr_item(a.in[16], 1024, 32 * (r & 31), WoT, 1024, 32 * (r & 31), 64 * (r >> 5), scr, lane); continue; }
        r -= I_O;
        if (r < I_UP) { const int kb = r / 176, nb = r % 176; tr_item(a.in[17], FF2, 32 * nb, WupT, 1024, 32 * nb, 64 * kb, scr, lane); continue; }
        r -= I_UP;
        { const int kb = r >> 5, nb = r & 31; tr_item(a.in[20], 1024, 32 * nb, WdnT, FF, 32 * nb, 64 * kb, scr, lane); }
    }
}
__device__ __forceinline__ void phase_modfin(const Args& a) {
    const int gt = blockIdx.x * 512 + threadIdx.x, NT = gridDim.x * 512;
    float* mod = (float*)(a.ws + WS_MOD); const float* part = (const float*)(a.ws + WS_PART);
    float* c0 = (float*)(a.ws + WS_C0); float* c1 = (float*)(a.ws + WS_C1);
    for (int i = gt; i < 5 * NMOD; i += NT) { const int v = i / NMOD, col = i % NMOD; float s = a.in[7][col];
#pragma unroll
        for (int ks = 0; ks < 8; ++ks) s += part[(size_t)(ks * 5 + v) * NMOD + col];
        mod[i] = s; }
    for (int i = gt; i < NP; i += NT) { float v0 = 0.f, v1 = 0.f;
        if (i >= 2048 && i < 3072) { const int j = i - 2048; const float a0 = a.in[13][j], a1 = a.in[13][1024 + j]; const float m = fmaxf(a0, a1);
            const float e0 = __expf(a0 - m), e1 = __expf(a1 - m), inv = 1.f / (e0 + e1); v0 = e0 * inv; v1 = e1 * inv; }
        else if (i >= 4096) v0 = a.in[12][i - 4096];
        c0[i] = v0; c1[i] = v1; }
}
__device__ __forceinline__ void phase_norm1(const Args& a, LAS unsigned char* L, bf16_t* XN) {
    phase_modfin(a);
    const int tid = threadIdx.x, lane = tid & 63, wave = tid >> 6;
    const int rbase = blockIdx.x * (MTOK / 256);
    const int mi = rbase < MP ? 0 : 1 + ((rbase - MP) >> 11);
    LAS float* lm = (LAS float*)L;
    const float* part = (const float*)(a.ws + WS_PART);
    __syncthreads();
#pragma unroll
    for (int j = 0; j < 4; ++j) { const int col = tid + 512 * j; float sacc = a.in[7][col];
#pragma unroll
        for (int ks = 0; ks < 8; ++ks) sacc += part[(size_t)(ks * 5 + mi) * NMOD + col];
        lm[col] = sacc; }
    __syncthreads();
    const float* g = a.in[8];
    for (int r = wave; r < MTOK / 256; r += 8) {
        const int row = rbase + r;
        const float* xr = row < MP ? a.in[0] + (size_t)row * D : a.in[1] + (size_t)(row - MP) * D;
        f32x4 v[4]; float sq = 0.f;
#pragma unroll
        for (int j = 0; j < 4; ++j) { v[j] = *(const f32x4*)(xr + 4 * lane + 256 * j); sq += (v[j][0] * v[j][0] + v[j][1] * v[j][1]) + (v[j][2] * v[j][2] + v[j][3] * v[j][3]); }
        const float rstd = rsqrtf(wave_sum(sq) * (1.f / D) + EPS);
#pragma unroll
        for (int j = 0; j < 4; ++j) { const int c = 4 * lane + 256 * j; const f32x4 gg = *(const f32x4*)(g + c), sc = *(const LAS f32x4*)(lm + 1024 + c), sh = *(const LAS f32x4*)(lm + c);
            const f32x4 h = v[j] * rstd * gg * (sc + 1.f) + sh; u32x2 o; o.x = cvtpk(h[0], h[1]); o.y = cvtpk(h[2], h[3]);
            *(u32x2*)(XN + (size_t)row * D + c) = o; }
    }
}
__device__ __forceinline__ void phase_final_norm(float* y, const float* g) {
    const int lane = threadIdx.x & 63, gw = blockIdx.x * 8 + (threadIdx.x >> 6), NGW = gridDim.x * 8;
    for (int row = gw; row < MTOK; row += NGW) {
        float* xr = y + (size_t)row * D; f32x4 v[4]; float s = 0.f;
#pragma unroll
        for (int j = 0; j < 4; ++j) { v[j] = *(const f32x4*)(xr + 4 * lane + 256 * j); s += (v[j][0] * v[j][0] + v[j][1] * v[j][1]) + (v[j][2] * v[j][2] + v[j][3] * v[j][3]); }
        const float rstd = rsqrtf(wave_sum(s) * (1.f / D) + EPS);
#pragma unroll
        for (int j = 0; j < 4; ++j) { const int c = 4 * lane + 256 * j; const f32x4 gg = *(const f32x4*)(g + c); *(f32x4*)(xr + c) = v[j] * rstd * gg; }
    }
}

constexpr size_t WS_SLOC = 206 * MiB, WS_DTOT = 238 * MiB;
static_assert(WS_P + (size_t)MTOK * NP * 2 <= WS_SLOC && WS_DTOT + 256 * 1024 <= 239 * MiB, "ws map");
template <int DK> struct ScanCfg {
    static constexpr int SA = DK == 128 ? 272 : 144, SV = 288;
    static constexpr int OFF_A = 0, OFF_B = 64 * SA, OFF_K = 128 * SA, OFF_V = 192 * SA, OFF_F = OFF_V + 64 * SV, OFF_R = OFF_F + 4 * DK * 4, OFF_L = OFF_R + 64 * 8 * 4, END = OFF_L + 64 * SA;
    static constexpr int OPITCH = 264, OFF_O = END;
    static_assert(OFF_O + 256 * OPITCH <= 163840 - 64, "LDS");
    static constexpr int NPAIR = DK / 2;
    static constexpr int NR = DK / 16, NK = DK / 32;
};
__device__ __forceinline__ s16x4 vtr(const LAS unsigned char* p) { return __builtin_bit_cast(s16x4, __builtin_amdgcn_ds_read_tr16_b64_v4i16((LAS s16x4*)p)); }

template <int DK, bool HG>
__device__ __forceinline__ void scan_load(u32x4 (&R)[HG ? 6 : 5], const bf16_t* P, int row0, int T, int dir, int sc, int qcol, int kcol, int lfcol, int vcol, int tid) {
    const bf16_t* pb = P + (size_t)(row0 + (dir ? T - 1 - 64 * sc : 64 * sc)) * NP;
#pragma unroll
    for (int j = 0; j < (HG ? 6 : 5); ++j) {
        int tl, col;
        if (HG) { const int p = (tid + 512 * j) & 1023; tl = p >> 4; col = (j < 2 ? qcol : (j < 4 ? lfcol : vcol)) + 8 * (p & 15); }
        else if (j < 3) { tl = tid >> 3; col = (j == 0 ? qcol : (j == 1 ? kcol : lfcol)) + 8 * (tid & 7); }
        else { const int p = tid + 512 * (j - 3); tl = p >> 4; col = vcol + 8 * (p & 15); }
        R[j] = *(const u32x4*)(pb + (dir ? -tl : tl) * NP + col);
    }
}
template <int DK, bool HG>
__device__ __forceinline__ void scan_stash(const u32x4 (&R)[HG ? 6 : 5], LAS unsigned char* L, int tid) {
    using C = ScanCfg<DK>;
#pragma unroll
    for (int j = 0; j < (HG ? 6 : 5); ++j) {
        int off;
        if (HG) { const int p = (tid + 512 * j) & 1023; const int tl = p >> 4, ch = p & 15; off = (j < 2 ? C::OFF_A + tl * C::SA : (j < 4 ? C::OFF_L + tl * C::SA : C::OFF_V + tl * C::SV)) + ch * 16; }
        else if (j < 3) { off = (j == 0 ? C::OFF_A : (j == 1 ? C::OFF_B : C::OFF_L)) + (tid >> 3) * C::SA + (tid & 7) * 16; }
        else { const int p = tid + 512 * (j - 3); off = C::OFF_V + (p >> 4) * C::SV + (p & 15) * 16; }
        *(LAS u32x4*)(L + off) = R[j];
    }
}
template <int DK, bool HG, bool LIGHT>
__device__ __forceinline__ void scan_item(LAS unsigned char* L, const bf16_t* P, float* OF, bf16_t* XN, int row0, int T,
                                          int qcol, int kcol, int lfcol_f, int lfcol_b, int vcol, int sgcol, int mcol,
                                          const float* s0f, const float* s0b, const float* cmb_s, const float* cmb_d, int seg, float* sof, float* sob, float* dtot, const float* gnorm) {
    using C = ScanCfg<DK>;
    const int tid = threadIdx.x, lane = tid & 63, wid = tid >> 6, fr = lane & 15, fq = lane >> 4, cb = wid * 16;
    const int nsc = T >> 6;
    const float gn = LIGHT ? 0.f : gnorm[cb + fr];
    for (int dir = 0; dir < 2; ++dir) {
        f32x4 S[C::NR], Dacc[LIGHT ? C::NR : 1];
        { const float* s0 = dir ? s0b : s0f;
#pragma unroll
          for (int r = 0; r < C::NR; ++r) { if (LIGHT) Dacc[r] = (f32x4){1.f, 1.f, 1.f, 1.f};
#pragma unroll
              for (int jj = 0; jj < 4; ++jj) S[r][jj] = s0 ? s0[(16 * r + fq * 4 + jj) * 128 + cb + fr] : 0.f; }
          if (cmb_s) {
              const int n = dir ? 7 - seg : seg;
              for (int q = 0; q < n; ++q) { const int sj = dir ? 7 - q : q;
                  const float* sl = cmb_s + (size_t)(sj * 2 + dir) * 16384; const float* dl = cmb_d + (size_t)(sj * 2 + dir) * 128;
#pragma unroll
                  for (int r = 0; r < C::NR; ++r) { const f32x4 dd = *(const f32x4*)(dl + 16 * r + fq * 4);
#pragma unroll
                      for (int jj = 0; jj < 4; ++jj) S[r][jj] = S[r][jj] * dd[jj] + sl[(16 * r + fq * 4 + jj) * 128 + cb + fr]; } } } }
        const int lfcol = dir ? lfcol_b : lfcol_f;
        u32x4 R[HG ? 6 : 5];
        scan_load<DK, HG>(R, P, row0, T, dir, 0, qcol, kcol, lfcol, vcol, tid);
#pragma unroll 1
        for (int sc = 0; sc < nsc; ++sc) {
            int tid_o = tid; asm volatile("" : "+v"(tid_o));
            const int fr_o = tid_o & 15, fq_o = (tid_o >> 4) & 3, cb_o = (tid_o >> 6) << 4;
            __syncthreads();
            scan_stash<DK, HG>(R, L, tid_o);
            if (sc + 1 < nsc) scan_load<DK, HG>(R, P, row0, T, dir, sc + 1, qcol, kcol, lfcol, vcol, tid_o);
            __syncthreads();
            if (tid < 8 * C::NPAIR) {
                const int c = tid / (2 * C::NPAIR), rem = tid % (2 * C::NPAIR), half = rem / C::NPAIR, d0 = 2 * (rem % C::NPAIR);
                unsigned lfv[16];
#pragma unroll
                for (int i = 0; i < 16; ++i) lfv[i] = *(const LAS unsigned*)(L + C::OFF_L + (16 * c + i) * C::SA + d0 * 2);
                float h00 = 0.f, h01 = 0.f, h10 = 0.f, h11 = 0.f;
#pragma unroll
                for (int i = 0; i < 8; ++i) { h00 += bf_lo(lfv[i]); h01 += bf_hi(lfv[i]); h10 += bf_lo(lfv[8 + i]); h11 += bf_hi(lfv[8 + i]); }
                const float bl0 = fmaxf(h00 + h10, -80.f), bl1 = fmaxf(h01 + h11, -80.f);
                const float f0 = fast_exp(bl0), f1 = fast_exp(bl1);
                if (half == 0) *(LAS f32x2_t*)(L + C::OFF_F + (c * DK + d0) * 4) = (f32x2_t){f0, f1};
                const unsigned hmask = 0u - (unsigned)half;
                float s0 = half ? h00 : 0.f, s1 = half ? h01 : 0.f;
#pragma unroll
                for (int i = 0; i < 8; ++i) {
                    const unsigned lu = lfv[i] ^ ((lfv[i] ^ lfv[8 + i]) & hmask);
                    s0 += bf_lo(lu); s1 += bf_hi(lu);
                    const float b0 = fmaxf(s0, -80.f), b1 = fmaxf(s1, -80.f);
                    const int o = (16 * c + 8 * half + i) * C::SA + d0 * 2;
                    float k0, k1;
                    if (HG) { k0 = 1.f - fast_exp(bf_lo(lu)); k1 = 1.f - fast_exp(bf_hi(lu)); }
                    else { const unsigned ku = *(const LAS unsigned*)(L + C::OFF_B + o); k0 = bf_lo(ku); k1 = bf_hi(ku); }
                    const float bq0 = k0 * fast_exp(-b0), bq1 = k1 * fast_exp(-b1);
                    if (!LIGHT) {
                        const unsigned qu = *(const LAS unsigned*)(L + C::OFF_A + o);
                        *(LAS unsigned*)(L + C::OFF_A + o) = cvtpk(bf_lo(qu) * fast_exp(b0), bf_hi(qu) * fast_exp(b1));
                        *(LAS unsigned*)(L + C::OFF_B + o) = cvtpk(bq0, bq1);
                    }
                    *(LAS unsigned*)(L + C::OFF_K + o) = cvtpk(bq0 * f0, bq1 * f1);
                }
            }
            __syncthreads();
            f32x4 obuf[4];
            LAS unsigned short* ol = (LAS unsigned short*)(L + C::OFF_O) + (dir ? 255 - 64 * sc - fq * 4 : 64 * sc + fq * 4) * (C::OPITCH / 2) + cb + fr;
#pragma unroll
            for (int c = 0; c < 4; ++c) {
                const s16x4 vb = vtr(L + C::OFF_V + (16 * c + fq * 4 + (fr >> 2)) * C::SV + (cb + 4 * (fr & 3)) * 2);
                f32x4 o = {0.f, 0.f, 0.f, 0.f};
                if (!LIGHT) {
                bf16x8 a1[C::NK], b1[C::NK];
                const LAS unsigned char* pa = L + C::OFF_A + (16 * c + fr) * C::SA + fq * 8;
                const LAS unsigned char* pb = L + C::OFF_B + (16 * c + fr) * C::SA + fq * 8;
#pragma unroll
                for (int kk = 0; kk < C::NK; ++kk) {
                    const s16x4 al = *(const LAS s16x4*)(pa + kk * 64), ah = *(const LAS s16x4*)(pa + kk * 64 + 32);
                    const s16x4 bl = *(const LAS s16x4*)(pb + kk * 64), bh = *(const LAS s16x4*)(pb + kk * 64 + 32);
                    a1[kk] = (bf16x8){al[0], al[1], al[2], al[3], ah[0], ah[1], ah[2], ah[3]};
                    b1[kk] = (bf16x8){bl[0], bl[1], bl[2], bl[3], bh[0], bh[1], bh[2], bh[3]};
                }
                f32x4 sT = {0.f, 0.f, 0.f, 0.f};
#pragma unroll
                for (int kk = 0; kk < C::NK; ++kk) sT = __builtin_amdgcn_mfma_f32_16x16x32_bf16(b1[kk], a1[kk], sT, 0, 0, 0);
#pragma unroll
                for (int jj = 0; jj < 4; ++jj) sT[jj] = (fq * 4 + jj <= fr) ? sT[jj] : 0.f;
                const unsigned p01 = cvtpk(sT[0], sT[1]), p23 = cvtpk(sT[2], sT[3]);
                const s16x4 pfrag = __builtin_bit_cast(s16x4, (u32x2){p01, p23});
                o = __builtin_amdgcn_mfma_f32_16x16x16bf16_1k(pfrag, vb, (f32x4){0.f, 0.f, 0.f, 0.f}, 0, 0, 0);
#pragma unroll
                for (int kk = 0; kk < C::NK; ++kk) {
                    const u32x4 sw = {cvtpk(S[2 * kk][0], S[2 * kk][1]), cvtpk(S[2 * kk][2], S[2 * kk][3]), cvtpk(S[2 * kk + 1][0], S[2 * kk + 1][1]), cvtpk(S[2 * kk + 1][2], S[2 * kk + 1][3])};
                    o = __builtin_amdgcn_mfma_f32_16x16x32_bf16(a1[kk], __builtin_bit_cast(bf16x8, sw), o, 0, 0, 0);
                }
                }
#pragma unroll
                for (int r = 0; r < C::NR; ++r) {
                    const f32x4 fc = *(const LAS f32x4*)(L + C::OFF_F + (c * DK + 16 * r + fq * 4) * 4);
                    const s16x4 ka = vtr(L + C::OFF_K + (16 * c + fq * 4 + (fr >> 2)) * C::SA + (16 * r + 4 * (fr & 3)) * 2);
                    S[r] = __builtin_amdgcn_mfma_f32_16x16x16bf16_1k(ka, vb, S[r] * fc, 0, 0, 0);
                    if (LIGHT) Dacc[r] = Dacc[r] * fc;
                }
#pragma unroll
                for (int jj = 0; jj < 4; ++jj) { if (LIGHT) continue;
                    if (dir == 0) ol[(16 * c + jj) * (C::OPITCH / 2)] = (unsigned short)(cvtpk(o[jj], o[jj]) & 0xffffu); else o[jj] += __uint_as_float((unsigned)ol[-(16 * c + jj) * (C::OPITCH / 2)] << 16); }
                obuf[c] = o;
            }
            if (!LIGHT && dir == 1) {
                unsigned sgp[4][2];
                { const bf16_t* gb = P + (size_t)(row0 + T - 1 - 64 * sc - fq_o * 4) * NP + sgcol + cb_o + fr_o;
#pragma unroll
                  for (int c = 0; c < 4; ++c)
#pragma unroll
                      for (int jj = 0; jj < 4; ++jj) { const unsigned sv = gb[-(16 * c + jj) * NP]; if (jj & 1) sgp[c][jj >> 1] |= sv << 16; else sgp[c][jj >> 1] = sv; } }
#pragma unroll
                for (int c = 0; c < 4; ++c)
#pragma unroll
                    for (int jj = 0; jj < 4; ++jj) { float ss = obuf[c][jj] * obuf[c][jj]; ss += __shfl_xor(ss, 1); ss += __shfl_xor(ss, 2); ss += __shfl_xor(ss, 4); ss += __shfl_xor(ss, 8);
                        if (fr == 0) *(LAS float*)(L + C::OFF_R + ((16 * c + fq * 4 + jj) * 8 + wid) * 4) = ss; }
                __syncthreads();
                bf16_t* xo = XN + (size_t)(row0 + T - 1 - 64 * sc - fq_o * 4) * D + mcol + cb_o + fr_o;
#pragma unroll
                for (int c = 0; c < 4; ++c)
#pragma unroll
                    for (int jj = 0; jj < 4; ++jj) { const int tl = 16 * c + fq * 4 + jj; const f32x4 r0 = *(const LAS f32x4*)(L + C::OFF_R + tl * 32), r1 = *(const LAS f32x4*)(L + C::OFF_R + tl * 32 + 16);
                        const float tot = ((r0[0] + r0[1]) + (r0[2] + r0[3])) + ((r1[0] + r1[1]) + (r1[2] + r1[3]));
                        const float rstd = rsqrtf(tot * (1.f / 128.f) + EPS);
                        const float sg = (jj & 1) ? bf_hi(sgp[c][jj >> 1]) : bf_lo(sgp[c][jj >> 1]);
                        const float val = obuf[c][jj] * rstd * gn * sg;
                        xo[-(16 * c + jj) * D] = (bf16_t)(cvtpk(val, val) & 0xffffu); }
            }
        }
        float* so = dir ? sob : sof;
        if (so) {
#pragma unroll
            for (int r = 0; r < C::NR; ++r)
#pragma unroll
                for (int jj = 0; jj < 4; ++jj) so[(16 * r + fq * 4 + jj) * 128 + cb + fr] = S[r][jj]; }
        if (LIGHT && wid == 0 && fr == 0) {
#pragma unroll
            for (int r = 0; r < C::NR; ++r) *(f32x4*)(dtot + dir * 128 + 16 * r + fq * 4) = Dacc[r]; }
    }
}

template <int DK, bool HG>
__device__ __forceinline__ void scan_light2(LAS unsigned char* L, const bf16_t* P, int row0, int kcol, int lfcol_f, int lfcol_b, int vcol, float* so_f, float* so_b, float* dtot) {
    constexpr int SA = DK * 2 + 32, SV = 288, NR = DK / 16, NPAIR = DK / 2;
    constexpr int OFF_L = 0, OFF_K = 128 * SA, OFF_V = 256 * SA, OFF_G = OFF_V + 128 * SV, OFF_F = OFF_G + 8 * DK * 4, OFF_T = OFF_F + DK * 4;
    static_assert(OFF_T + DK * 4 <= 147392, "LDS");
    const int tid0 = threadIdx.x;
#pragma unroll 1
    for (int dir = 0; dir < 2; ++dir) {
        const int lfcol = dir ? lfcol_b : lfcol_f;
        f32x4 S[NR];
#pragma unroll
        for (int r = 0; r < NR; ++r) S[r] = (f32x4){0.f, 0.f, 0.f, 0.f};
        u32x4 R[8];
#pragma unroll 1
        for (int st = 0; st < 2; ++st) {
            int tid = tid0; asm volatile("" : "+v"(tid));
            const int lane = tid & 63, wid = tid >> 6, fr = lane & 15, fq = lane >> 4, cb = wid * 16;
            {
                const bf16_t* pb = P + (size_t)(row0 + (dir ? 255 - 128 * st : 128 * st)) * NP;
#pragma unroll
                for (int j = 0; j < 8; ++j) {
                    int tl, col;
                    if (j >= 4) { const int p = tid + 512 * (j - 4); tl = p >> 4; col = vcol + 8 * (p & 15); }
                    else if (HG) { const int p = tid + 512 * j; tl = p >> 4; col = lfcol + 8 * (p & 15); }
                    else { const int p = tid + 512 * (j & 1); tl = p >> 3; col = (j < 2 ? lfcol : kcol) + 8 * (p & 7); }
                    R[j] = *(const u32x4*)(pb + (dir ? -tl : tl) * NP + col);
                }
            }
            __syncthreads();
#pragma unroll
            for (int j = 0; j < 8; ++j) {
                int off;
                if (j >= 4) { const int p = tid + 512 * (j - 4); off = OFF_V + (p >> 4) * SV + (p & 15) * 16; }
                else if (HG) { const int p = tid + 512 * j; off = OFF_L + (p >> 4) * SA + (p & 15) * 16; }
                else { const int p = tid + 512 * (j & 1); off = (j < 2 ? OFF_L : OFF_K) + (p >> 3) * SA + (p & 7) * 16; }
                *(LAS u32x4*)(L + off) = R[j];
            }
            __syncthreads();
            const bool act = tid < 8 * NPAIR;
            const int g = tid / NPAIR, d0 = 2 * (tid % NPAIR);
            unsigned lfv[16]; float s0 = 0.f, s1 = 0.f;
            if (act) {
#pragma unroll
                for (int i = 0; i < 16; ++i) { lfv[i] = *(const LAS unsigned*)(L + OFF_L + (16 * g + i) * SA + d0 * 2); s0 += bf_lo(lfv[i]); s1 += bf_hi(lfv[i]); }
                *(LAS f32x2_t*)(L + OFF_G + (g * DK + d0) * 4) = (f32x2_t){s0, s1};
            }
            __syncthreads();
            if (act) {
                float a0 = 0.f, a1 = 0.f;
#pragma unroll
                for (int gp = 1; gp < 8; ++gp) { const f32x2_t t = *(const LAS f32x2_t*)(L + OFF_G + (gp * DK + d0) * 4); if (gp > g) { a0 += t.x; a1 += t.y; } }
                if (g == 0) { const float t0 = s0 + a0, t1 = s1 + a1;
                    *(LAS f32x2_t*)(L + OFF_F + d0 * 4) = (f32x2_t){fast_exp(fmaxf(t0, -80.f)), fast_exp(fmaxf(t1, -80.f))};
                    LAS f32x2_t* tp = (LAS f32x2_t*)(L + OFF_T + d0 * 4); if (st == 0) *tp = (f32x2_t){t0, t1}; else { const f32x2_t o = *tp; *tp = (f32x2_t){o.x + t0, o.y + t1}; } }
#pragma unroll
                for (int i = 15; i >= 0; --i) {
                    const int o = (16 * g + i) * SA + d0 * 2;
                    float k0, k1;
                    if (HG) { k0 = 1.f - fast_exp(bf_lo(lfv[i])); k1 = 1.f - fast_exp(bf_hi(lfv[i])); }
                    else { const unsigned ku = *(const LAS unsigned*)(L + OFF_K + o); k0 = bf_lo(ku); k1 = bf_hi(ku); }
                    *(LAS unsigned*)(L + OFF_K + o) = cvtpk(k0 * fast_exp(fmaxf(a0, -80.f)), k1 * fast_exp(fmaxf(a1, -80.f)));
                    a0 += bf_lo(lfv[i]); a1 += bf_hi(lfv[i]);
                }
            }
            __syncthreads();
#pragma unroll
            for (int r = 0; r < NR; ++r) { const f32x4 fd = *(const LAS f32x4*)(L + OFF_F + (16 * r + fq * 4) * 4); S[r] = S[r] * fd; }
#pragma unroll
            for (int ks = 0; ks < 4; ++ks) {
                const int rb = 32 * ks + fq * 8 + (fr >> 2);
                const s16x4 vl = vtr(L + OFF_V + rb * SV + (cb + 4 * (fr & 3)) * 2), vh = vtr(L + OFF_V + (rb + 4) * SV + (cb + 4 * (fr & 3)) * 2);
                const bf16x8 vb = (bf16x8){vl[0], vl[1], vl[2], vl[3], vh[0], vh[1], vh[2], vh[3]};
#pragma unroll
                for (int r = 0; r < NR; ++r) {
                    const s16x4 kl = vtr(L + OFF_K + rb * SA + (16 * r + 4 * (fr & 3)) * 2), kh = vtr(L + OFF_K + (rb + 4) * SA + (16 * r + 4 * (fr & 3)) * 2);
                    const bf16x8 ka = (bf16x8){kl[0], kl[1], kl[2], kl[3], kh[0], kh[1], kh[2], kh[3]};
                    S[r] = __builtin_amdgcn_mfma_f32_16x16x32_bf16(ka, vb, S[r], 0, 0, 0);
                }
            }
            if (st == 1) {
                float* so = dir ? so_b : so_f;
#pragma unroll
                for (int r = 0; r < NR; ++r)
#pragma unroll
                    for (int jj = 0; jj < 4; ++jj) so[(16 * r + fq * 4 + jj) * 128 + cb + fr] = S[r][jj];
                if (tid < DK) dtot[dir * 128 + tid] = fast_exp(fmaxf(*(const LAS float*)(L + OFF_T + tid * 4), -80.f));
            }
        }
    }
}

__device__ __forceinline__ void phase_scan_light(const Args& a, LAS unsigned char* L) {
    const bf16_t* P = (const bf16_t*)(a.ws + WS_P);
    for (int j = blockIdx.x; j < 256; j += gridDim.x) {
        const int b = j >> 6, hh = (j >> 3) & 7, seg = j & 7, h = hh & 3, row0 = MP + b * 2048 + seg * 256;
        float* sl = (float*)(a.ws + WS_SLOC) + (size_t)j * 2 * 16384; float* dt = (float*)(a.ws + WS_DTOT) + (size_t)j * 2 * 128;
        if (hh < 4) scan_light2<64, false>(L, P, row0, 256 + h * 64, 4096 + h * 64, 4352 + h * 64, 512 + h * 128, sl, sl + 16384, dt);
        else scan_light2<128, true>(L, P, row0, 0, 2048 + h * 128, 2560 + h * 128, 3072 + h * 128, sl, sl + 16384, dt);
    }
}
__device__ __forceinline__ void phase_scan(const Args& a, LAS unsigned char* L) {
    const bf16_t* P = (const bf16_t*)(a.ws + WS_P); bf16_t* XN = (bf16_t*)(a.ws + WS_XN); float* OF = a.out;
    float* og = a.out + (size_t)MTOK * D; float* oh = og + 32 * 2 * 4 * 64 * 128;
    for (int j = blockIdx.x; j < 512; j += gridDim.x) {
        const bool samp = j >= 256; int b, hh, seg = 0, row0;
        if (samp) { const int q = j - 256;
            b = q >> 6; hh = ((((q >> 2) & 1) ^ 1) << 2) | ((q >> 3) & 3); seg = (((q >> 5) & 1) << 2) | (q & 3); row0 = MP + b * 2048 + seg * 256; } else { b = j >> 3; hh = j & 7; row0 = b * 256; }
        const int h = hh & 3;
        const int li0 = (b * 8 + hh) * 8;
        const float* cs = samp ? (const float*)(a.ws + WS_SLOC) + (size_t)li0 * 2 * 16384 : nullptr;
        const float* cd = samp ? (const float*)(a.ws + WS_DTOT) + (size_t)li0 * 2 * 128 : nullptr;
        if (hh < 4) {
            const size_t so = (size_t)(b * 2 * 4 + h) * 64 * 128, sd = (size_t)4 * 64 * 128;
            scan_item<64, false, false>(L, P, OF, XN, row0, 256, h * 64, 256 + h * 64, 4096 + h * 64, 4352 + h * 64, 512 + h * 128, 1024 + h * 128, h * 128,
                                       samp ? a.in[2] + so : nullptr, samp ? a.in[2] + so + sd : nullptr, cs, cd, seg, samp ? nullptr : og + so, samp ? nullptr : og + so + sd, nullptr, a.in[14]);
        } else {
            const size_t so = (size_t)(b * 2 * 4 + h) * 128 * 128, sd = (size_t)4 * 128 * 128;
            scan_item<128, true, false>(L, P, OF, XN, row0, 256, 1536 + h * 128, 0, 2048 + h * 128, 2560 + h * 128, 3072 + h * 128, 3584 + h * 128, 512 + h * 128,
                                       samp ? a.in[3] + so : nullptr, samp ? a.in[3] + so + sd : nullptr, cs, cd, seg, samp ? nullptr : oh + so, samp ? nullptr : oh + so + sd, nullptr, a.in[15]);
        }
    }
}

#define OPAQUE(p) asm volatile("" : "+v"(p))
template <bool GRID>
__device__ __forceinline__ void conv_load(u32x4 (&R)[GRID ? 13 : 5], u32x4 (&W)[2], const bf16_t* U, const float* cw, const float* cbias, int it, int tid) {
    constexpr int NR = GRID ? 3 : 1, NT = GRID ? 9 : 3, NPJ = GRID ? 13 : 5, TOT = NR * 66 * 32;
    const int span = it / 22, cb = it % 22;
    const bf16_t* ub = U + (size_t)span * 64 * FF2 + cb * 128; OPAQUE(ub);
#pragma unroll
    for (int j = 0; j < NPJ; ++j) {
        const int p = tid + 512 * j;
        const int rr = p / (66 * 32), rem = p % (66 * 32), s = rem >> 5, pc = rem & 31;
        bool ok; int roff;
        if (GRID) { const int r = (span & 31) + rr - 1; ok = (p < TOT) & (r >= 0) & (r < 32) & (s >= 1) & (s <= 64); roff = (rr - 1) * 64 + s - 1; }
        else { ok = (p < TOT) & (((s >= 1) & (s <= 64)) | ((s == 0) & ((span & 3) != 0)) | ((s == 65) & ((span & 3) != 3))); roff = s - 1; }
        const int off = ok ? roff * FF2 + (pc < 16 ? pc * 8 : FF + (pc - 16) * 8) : 0;
        u32x4 v = *(const u32x4*)(ub + off);
        const unsigned m = ok ? 0xffffffffu : 0u;
        v.x &= m; v.y &= m; v.z &= m; v.w &= m;
        R[j] = v;
    }
#pragma unroll
    for (int j = 0; j < 2; ++j) {
        const int p = tid + 512 * j;
        const bool isw = p < NT * 64; const int q = isw ? p : (p < NT * 64 + 64 ? p - NT * 64 : 0);
        const int tap = q >> 6, g = (q >> 5) & 1, c4 = q & 31;
        const float* src = isw ? cw + (size_t)(GRID ? tap : 3 + tap) * FF2 : cbias;
        W[j] = *(const u32x4*)(src + g * FF + cb * 128 + c4 * 4);
    }
}
__device__ __forceinline__ void conv_fma(float (&ag)[8], float (&au)[8], const u32x4 gv, const u32x4 uv, const LAS float* wg) {
    const f32x4 wg0 = *(const LAS f32x4*)wg, wg1 = *(const LAS f32x4*)(wg + 4), wu0 = *(const LAS f32x4*)(wg + 128), wu1 = *(const LAS f32x4*)(wg + 132);
    ag[0] += bf_lo(gv[0]) * wg0[0]; ag[1] += bf_hi(gv[0]) * wg0[1]; ag[2] += bf_lo(gv[1]) * wg0[2]; ag[3] += bf_hi(gv[1]) * wg0[3];
    ag[4] += bf_lo(gv[2]) * wg1[0]; ag[5] += bf_hi(gv[2]) * wg1[1]; ag[6] += bf_lo(gv[3]) * wg1[2]; ag[7] += bf_hi(gv[3]) * wg1[3];
    au[0] += bf_lo(uv[0]) * wu0[0]; au[1] += bf_hi(uv[0]) * wu0[1]; au[2] += bf_lo(uv[1]) * wu0[2]; au[3] += bf_hi(uv[1]) * wu0[3];
    au[4] += bf_lo(uv[2]) * wu1[0]; au[5] += bf_hi(uv[2]) * wu1[1]; au[6] += bf_lo(uv[3]) * wu1[2]; au[7] += bf_hi(uv[3]) * wu1[3];
}
template <bool GRID>
__device__ __forceinline__ void phase_conv(const Args& a, LAS unsigned char* L, const bf16_t* U, bf16_t* Aff) {
    constexpr int NR = GRID ? 3 : 1, NT = GRID ? 9 : 3, NPJ = GRID ? 13 : 5, TOT = NR * 66 * 32;
    constexpr int ROWB = 66 * 512, OFF_W = NR * ROWB;
    const float* cw = a.in[18]; const float* cbias = a.in[19];
    const int tid0 = threadIdx.x;
    u32x4 R[NPJ], W[2];
    int it = blockIdx.x;
#pragma unroll 1
    for (; it < 128 * 22; it += gridDim.x) {
        int tid = tid0; asm volatile("" : "+v"(tid));
        const int cgl = tid & 15, tp = tid >> 4;
        conv_load<GRID>(R, W, U, cw, cbias, it, tid);
        __syncthreads();
#pragma unroll
        for (int j = 0; j < NPJ; ++j) { const int p = tid + 512 * j; if (p < TOT) *(LAS u32x4*)(L + p * 16) = R[j]; }
#pragma unroll
        for (int j = 0; j < 2; ++j) { const int p = tid + 512 * j; if (p < NT * 64 + 64) *(LAS u32x4*)(L + OFF_W + p * 16) = W[j]; }
        const int span = it / 22, cb = it % 22;
        __syncthreads();
        float ag[2][8], au[2][8];
        { const LAS float* bl = (const LAS float*)(L + OFF_W + NT * 1024);
          const f32x4 g0 = *(const LAS f32x4*)(bl + cgl * 8), g1 = *(const LAS f32x4*)(bl + cgl * 8 + 4), u0 = *(const LAS f32x4*)(bl + 128 + cgl * 8), u1 = *(const LAS f32x4*)(bl + 128 + cgl * 8 + 4);
#pragma unroll
          for (int t = 0; t < 2; ++t)
#pragma unroll
              for (int e = 0; e < 4; ++e) { ag[t][e] = g0[e]; ag[t][4 + e] = g1[e]; au[t][e] = u0[e]; au[t][4 + e] = u1[e]; } }
#pragma unroll 1
        for (int rr = 0; rr < NR; ++rr) {
#pragma unroll
            for (int cs = 0; cs < 4; ++cs) {
                const LAS unsigned char* tp_ = L + rr * ROWB + (2 * tp + cs) * 512 + cgl * 16;
                const u32x4 gv = *(const LAS u32x4*)tp_, uv = *(const LAS u32x4*)(tp_ + 256);
                if (cs <= 2) conv_fma(ag[0], au[0], gv, uv, (const LAS float*)(L + OFF_W) + (rr * 3 + cs) * 256 + cgl * 8);
                if (cs >= 1) conv_fma(ag[1], au[1], gv, uv, (const LAS float*)(L + OFF_W) + (rr * 3 + cs - 1) * 256 + cgl * 8);
            }
        }
#pragma unroll
        for (int t = 0; t < 2; ++t) {
            u32x4 o;
            o.x = cvtpk(silu_f(ag[t][0]) * au[t][0], silu_f(ag[t][1]) * au[t][1]); o.y = cvtpk(silu_f(ag[t][2]) * au[t][2], silu_f(ag[t][3]) * au[t][3]);
            o.z = cvtpk(silu_f(ag[t][4]) * au[t][4], silu_f(ag[t][5]) * au[t][5]); o.w = cvtpk(silu_f(ag[t][6]) * au[t][6], silu_f(ag[t][7]) * au[t][7]);
            *(u32x4*)(Aff + (size_t)(span * 64 + 2 * tp + t) * FF + cb * 128 + cgl * 8) = o;
        }
    }
}

__device__ __forceinline__ void conv_fma64(float (&ag)[8], float (&au)[8], const float (&g)[8], const float (&u)[8], const LAS float* wg) {
    const f32x4 wg0 = *(const LAS f32x4*)wg, wg1 = *(const LAS f32x4*)(wg + 4), wu0 = *(const LAS f32x4*)(wg + 64), wu1 = *(const LAS f32x4*)(wg + 68);
#pragma unroll
    for (int e = 0; e < 4; ++e) { ag[e] += g[e] * wg0[e]; ag[4 + e] += g[4 + e] * wg1[e]; au[e] += u[e] * wu0[e]; au[4 + e] += u[4 + e] * wu1[e]; }
}
__device__ __forceinline__ void phase_conv_grid4(const Args& a, LAS unsigned char* L, const bf16_t* U, bf16_t* Aff) {
    constexpr int ROWB = 66 * 256, TOT = 6 * 66 * 16, OFF_W = 6 * ROWB, NIT = 32 * 44;
    const float* cw = a.in[18]; const float* cbias = a.in[19];
    const int tid0 = threadIdx.x;
#pragma unroll 1
    for (int it = blockIdx.x; it < NIT; it += gridDim.x) {
        int tid = tid0; asm volatile("" : "+v"(tid));
        const int q4 = it / 44, cb = it % 44, batch = q4 >> 3, r0 = (q4 & 7) * 4;
        u32x4 R[13], W;
        { const bf16_t* ub = U + (size_t)(batch * 2048 + r0 * 64) * FF2 + cb * 64;
#pragma unroll
          for (int j = 0; j < 13; ++j) {
              const int p = tid + 512 * j;
              const int rr = p / 1056, rem = p % 1056, sl = rem >> 4, pc = rem & 15, r = r0 + rr - 1;
              const bool ok = (p < TOT) & (r >= 0) & (r < 32) & (sl >= 1) & (sl <= 64);
              const int off = ok ? ((rr - 1) * 64 + sl - 1) * FF2 + (pc < 8 ? pc * 8 : FF + (pc - 8) * 8) : 0;
              u32x4 v = *(const u32x4*)(ub + (ok ? off : 64 * FF2));
              const unsigned m = ok ? 0xffffffffu : 0u; v.x &= m; v.y &= m; v.z &= m; v.w &= m; R[j] = v; }
          const int p = tid < 320 ? tid : 0; const bool isw = p < 288; const int qq = isw ? p : p - 288;
          const int tap = qq >> 5, g = (qq >> 4) & 1, c4 = qq & 15;
          W = *(const u32x4*)((isw ? cw + (size_t)tap * FF2 : cbias) + g * FF + cb * 64 + c4 * 4); }
        __syncthreads();
#pragma unroll
        for (int j = 0; j < 13; ++j) { const int p = tid + 512 * j; if (p < TOT) *(LAS u32x4*)(L + p * 16) = R[j]; }
        if (tid < 320) *(LAS u32x4*)(L + OFF_W + tid * 16) = W;
        __syncthreads();
        const int cgl = tid & 7, w = tid >> 3;
        float ag[4][8], au[4][8];
        { const LAS float* bl = (const LAS float*)(L + OFF_W + 9 * 512);
          const f32x4 g0 = *(const LAS f32x4*)(bl + cgl * 8), g1 = *(const LAS f32x4*)(bl + cgl * 8 + 4), u0 = *(const LAS f32x4*)(bl + 64 + cgl * 8), u1 = *(const LAS f32x4*)(bl + 64 + cgl * 8 + 4);
#pragma unroll
          for (int t = 0; t < 4; ++t)
#pragma unroll
              for (int e = 0; e < 4; ++e) { ag[t][e] = g0[e]; ag[t][4 + e] = g1[e]; au[t][e] = u0[e]; au[t][4 + e] = u1[e]; } }
#pragma unroll 1
        for (int kw = 0; kw < 3; ++kw) {
#pragma unroll
            for (int rr = 0; rr < 6; ++rr) {
                const LAS unsigned char* tp_ = L + rr * ROWB + (w + kw) * 256 + cgl * 16;
                const u32x4 gv = *(const LAS u32x4*)tp_, uv = *(const LAS u32x4*)(tp_ + 128);
                float g[8], u[8];
#pragma unroll
                for (int e = 0; e < 4; ++e) { g[2 * e] = bf_lo(gv[e]); g[2 * e + 1] = bf_hi(gv[e]); u[2 * e] = bf_lo(uv[e]); u[2 * e + 1] = bf_hi(uv[e]); }
#pragma unroll
                for (int kh = 0; kh < 3; ++kh) { const int ro = rr - kh; if (ro >= 0 && ro <= 3) conv_fma64(ag[ro], au[ro], g, u, (const LAS float*)(L + OFF_W) + (kh * 3 + kw) * 128 + cgl * 8); }
            }
        }
#pragma unroll
        for (int t = 0; t < 4; ++t) {
            u32x4 o;
            o.x = cvtpk(silu_f(ag[t][0]) * au[t][0], silu_f(ag[t][1]) * au[t][1]); o.y = cvtpk(silu_f(ag[t][2]) * au[t][2], silu_f(ag[t][3]) * au[t][3]);
            o.z = cvtpk(silu_f(ag[t][4]) * au[t][4], silu_f(ag[t][5]) * au[t][5]); o.w = cvtpk(silu_f(ag[t][6]) * au[t][6], silu_f(ag[t][7]) * au[t][7]);
            *(u32x4*)(Aff + (size_t)(batch * 2048 + (r0 + t) * 64 + w) * FF + cb * 64 + cgl * 8) = o;
        }
    }
}

__device__ __forceinline__ void conv_seq_load(u32x4 (&R)[8], u32x4& W, const bf16_t* U, const float* cw, const float* cbias, int it, int tid) {
    const int b = it / 44, cb = it % 44;
        { const bf16_t* ub = U + (size_t)b * 256 * FF2 + cb * 64;
#pragma unroll
          for (int j = 0; j < 8; ++j) { const int p = tid + 512 * j, t = p >> 4, pc = p & 15; R[j] = *(const u32x4*)(ub + (size_t)t * FF2 + (pc < 8 ? pc * 8 : FF + (pc - 8) * 8)); }
          const int p = tid < 128 ? tid : 0; const bool isw = p < 96; const int qq = isw ? p : p - 96;
          const int tap = qq >> 5, g = (qq >> 4) & 1, c4 = qq & 15;
          W = *(const u32x4*)((isw ? cw + (size_t)tap * FF2 : cbias) + g * FF + cb * 64 + c4 * 4); }
}
__device__ __forceinline__ void phase_conv_seq(const Args& a, LAS unsigned char* L, const bf16_t* U, bf16_t* Aff) {
    constexpr int OFF_W = 258 * 256, NIT = 32 * 44;
    const float* cw = a.in[18] + 3 * FF2; const float* cbias = a.in[19];
    const int tid0 = threadIdx.x;
    __syncthreads();
    if (tid0 < 32) { const int side = tid0 >> 4, pc = tid0 & 15; *(LAS u32x4*)(L + (side ? 257 : 0) * 256 + pc * 16) = (u32x4){0u, 0u, 0u, 0u}; }
    u32x4 R[8], W;
    if ((int)blockIdx.x < NIT) conv_seq_load(R, W, U, cw, cbias, blockIdx.x, tid0);
#pragma unroll 1
    for (int it = blockIdx.x; it < NIT; it += gridDim.x) {
        int tid = tid0; asm volatile("" : "+v"(tid));
        const int b = it / 44, cb = it % 44;
        __syncthreads();
#pragma unroll
        for (int j = 0; j < 8; ++j) { const int p = tid + 512 * j; *(LAS u32x4*)(L + 256 + p * 16) = R[j]; }
        if (tid < 128) *(LAS u32x4*)(L + OFF_W + tid * 16) = W;
        if (it + (int)gridDim.x < NIT) conv_seq_load(R, W, U, cw, cbias, it + gridDim.x, tid);
        __syncthreads();
        const int cgl = tid & 7, tq = tid >> 3;
        float ag[4][8], au[4][8];
        { const LAS float* bl = (const LAS float*)(L + OFF_W + 3 * 512);
          const f32x4 g0 = *(const LAS f32x4*)(bl + cgl * 8), g1 = *(const LAS f32x4*)(bl + cgl * 8 + 4), u0 = *(const LAS f32x4*)(bl + 64 + cgl * 8), u1 = *(const LAS f32x4*)(bl + 64 + cgl * 8 + 4);
#pragma unroll
          for (int t = 0; t < 4; ++t)
#pragma unroll
              for (int e = 0; e < 4; ++e) { ag[t][e] = g0[e]; ag[t][4 + e] = g1[e]; au[t][e] = u0[e]; au[t][4 + e] = u1[e]; } }
#pragma unroll
        for (int cs = 0; cs < 6; ++cs) {
            const LAS unsigned char* tp_ = L + (4 * tq + cs) * 256 + cgl * 16;
            const u32x4 gv = *(const LAS u32x4*)tp_, uv = *(const LAS u32x4*)(tp_ + 128);
            float g[8], u[8];
#pragma unroll
            for (int e = 0; e < 4; ++e) { g[2 * e] = bf_lo(gv[e]); g[2 * e + 1] = bf_hi(gv[e]); u[2 * e] = bf_lo(uv[e]); u[2 * e + 1] = bf_hi(uv[e]); }
#pragma unroll
            for (int t = 0; t < 4; ++t) { const int kw = cs - t; if (kw >= 0 && kw <= 2) conv_fma64(ag[t], au[t], g, u, (const LAS float*)(L + OFF_W) + kw * 128 + cgl * 8); }
        }
#pragma unroll
        for (int t = 0; t < 4; ++t) {
            u32x4 o;
            o.x = cvtpk(silu_f(ag[t][0]) * au[t][0], silu_f(ag[t][1]) * au[t][1]); o.y = cvtpk(silu_f(ag[t][2]) * au[t][2], silu_f(ag[t][3]) * au[t][3]);
            o.z = cvtpk(silu_f(ag[t][4]) * au[t][4], silu_f(ag[t][5]) * au[t][5]); o.w = cvtpk(silu_f(ag[t][6]) * au[t][6], silu_f(ag[t][7]) * au[t][7]);
            *(u32x4*)(Aff + (size_t)(b * 256 + 4 * tq + t) * FF + cb * 64 + cgl * 8) = o;
        }
    }
}

#define XB_TMO      128
#define XB_XCNT(j)  (256  + 64 * (j))
#define XB_XSUB(j)  (1280 + 64 * (j))
#define XB_XGEN(j)  (2304 + 64 * (j))
#define XB_TOP      3328
#define XB_TOPGEN   3392
#define XCD_BAR_WORDS 3456
#define XB_SPIN_CAP (1u << 18)

__device__ __forceinline__ unsigned xb_ld(unsigned* p)              { return __hip_atomic_load(p, __ATOMIC_RELAXED, __HIP_MEMORY_SCOPE_AGENT); }
__device__ __forceinline__ unsigned xb_add(unsigned* p, unsigned v) { return __hip_atomic_fetch_add(p, v, __ATOMIC_RELAXED, __HIP_MEMORY_SCOPE_AGENT); }
__device__ __forceinline__ unsigned xb_xcc_id() { return (unsigned)__builtin_amdgcn_s_getreg((3 << 11) | 20) & 0xFu; }
#define XB_SPIN(cond, bar) do { unsigned _sp = 0; while (cond) { __builtin_amdgcn_s_sleep(1); \
    if ((++_sp & 255u) == 0u) { if (xb_ld(&(bar)[XB_TMO])) break; if (_sp > XB_SPIN_CAP) { atomicAdd(&(bar)[XB_TMO], 1u); break; } } } } while (0)

struct XcdBarrier {
    unsigned* bar; unsigned x;
    volatile LAS unsigned* st;
};

__device__ __forceinline__ XcdBarrier xcd_barrier_post(unsigned* bar, volatile LAS unsigned* st) {
    XcdBarrier b; b.bar = bar; b.x = xb_xcc_id(); b.st = st;
    if (threadIdx.x == 0) (void)xb_add(&bar[XB_XCNT(b.x)], 1u);
    return b;
}
__device__ __forceinline__ void xcd_barrier_complete(unsigned* bar, unsigned x, unsigned& nloc, unsigned& nx) {
    const unsigned G = gridDim.x * gridDim.y * gridDim.z;
    unsigned sum, cnt, mine, sp = 0u;
    for (;;) {
        sum = 0u; cnt = 0u; mine = 0u;
#pragma unroll
        for (unsigned j = 0; j < 16; ++j) { const unsigned c = xb_ld(&bar[XB_XCNT(j)]); sum += c; cnt += (c > 0u) ? 1u : 0u; mine = (j == x) ? c : mine; }
        if (sum == G) break;
        __builtin_amdgcn_s_sleep(1);
        if ((++sp & 255u) == 0u) { if (xb_ld(&bar[XB_TMO])) break; if (sp > XB_SPIN_CAP) { atomicAdd(&bar[XB_TMO], 1u); break; } }
    }
    nloc = mine > 0u ? mine : 1u; nx = cnt > 0u ? cnt : 1u;
}

__device__ __forceinline__ void xcd_barrier(const XcdBarrier& b) {
    asm volatile("s_waitcnt vmcnt(0)" ::: "memory");
    __syncthreads();
    if (threadIdx.x == 0) {
        unsigned* bar = b.bar;
        __builtin_amdgcn_s_waitcnt(0);
        unsigned nloc = b.st[0], nx = b.st[1];
        if (nloc == 0u) { xcd_barrier_complete(bar, b.x, nloc, nx); b.st[0] = nloc; b.st[1] = nx; }
        const unsigned old = xb_add(&bar[XB_XSUB(b.x)], 1u);
        const unsigned gen = old / nloc;
        if (old + 1u == (gen + 1u) * nloc) {
            __builtin_amdgcn_fence(__ATOMIC_RELEASE, "agent");
            asm volatile("s_waitcnt vmcnt(0)" ::: "memory");
            const unsigned og = xb_add(&bar[XB_TOP], 1u);
            const unsigned tg = og / nx;
            if (og + 1u == (tg + 1u) * nx) xb_add(&bar[XB_TOPGEN], 1u);
            else XB_SPIN(xb_ld(&bar[XB_TOPGEN]) == tg, bar);
            __builtin_amdgcn_fence(__ATOMIC_ACQUIRE, "agent");
            xb_add(&bar[XB_XGEN(b.x)], 1u);
            asm volatile("s_waitcnt vmcnt(0)" ::: "memory");
        } else {
            XB_SPIN(xb_ld(&bar[XB_XGEN(b.x)]) == gen, bar);
            __builtin_amdgcn_fence(__ATOMIC_ACQUIRE, "agent");
            asm volatile("s_waitcnt vmcnt(0)" ::: "memory");
        }
    }
    __syncthreads();
}

__device__ __forceinline__ Args load_args() {
    Args r{};
#if defined(__HIP_DEVICE_COMPILE__)
    typedef __attribute__((address_space(4))) const Args* CArgs;
    CArgs q = (CArgs)__builtin_amdgcn_kernarg_segment_ptr(); asm volatile("" : "+s"(q));
#pragma unroll
    for (int i = 0; i < 22; ++i) r.in[i] = q->in[i];
    r.out = q->out; r.ws = q->ws; r.ph_lo = q->ph_lo; r.ph_hi = q->ph_hi;
#endif
    return r;
}
__global__ void __launch_bounds__(512, 2) fwd_mega(Args a_unused) {
    extern __shared__ __attribute__((aligned(16))) unsigned char lds_raw[];
    LAS unsigned char* L = (LAS unsigned char*)lds_raw;
    cg::grid_group grid = cg::this_grid();
    int lo, hi; unsigned* barw; { const Args a0 = load_args(); lo = a0.ph_lo; hi = a0.ph_hi; barw = (unsigned*)(a0.ws + WS_BAR); }
    if (threadIdx.x < 2) ((volatile LAS unsigned*)(L + LDS_MISC))[threadIdx.x] = 0u;
    __syncthreads();
    const XcdBarrier bar = xcd_barrier_post(barw, (volatile LAS unsigned*)(L + LDS_MISC));
    if (hi > 1000) grid.sync();
#define PHASE_VARS const Args a = load_args(); unsigned char* ws = a.ws; bf16_t* XN = (bf16_t*)(ws + WS_XN); const float* mod = (const float*)(ws + WS_MOD); (void)XN; (void)mod;
#define IN(k) (lo <= (k) && (k) < hi)
#define SEAM(k) do { if (IN(k) && IN((k) + 1)) xcd_barrier(bar); } while (0)
    if (IN(0)) { PHASE_VARS phase_prep(a, L); } SEAM(0);
    if (IN(1)) { PHASE_VARS phase_norm1(a, L, XN); } SEAM(1);
    if (IN(2)) { PHASE_VARS pg8::Gemm g{XN, (const bf16_t*)(ws + WS_WIN), MTOK, NP, D}; pg8::StaticOrder S; S.init(MTOK, NP, gridDim.x, blockIdx.x);
        pg8::EpiProj E{(bf16_t*)(ws + WS_P), (const float*)(ws + WS_C0), (const float*)(ws + WS_C1)};
        pg8::gemm_phase<pg8::EpiProj, pg8::StaticOrder, true, true>(L, g, S, E);
        if (gridDim.x == 256 && blockIdx.x >= 128) phase_prep_late(a, L, 128); else if (gridDim.x != 256) phase_prep_late(a, L, 0); } SEAM(2);
    if (IN(3)) { PHASE_VARS phase_scan_light(a, L); } SEAM(3);
    if (IN(4)) { PHASE_VARS phase_scan(a, L); } SEAM(4);
    if (IN(5)) { PHASE_VARS pg8::Gemm g{XN, (const bf16_t*)(ws + WS_WO), MTOK, D, D}; pg8::StaticOrder S; S.init(MTOK, D, gridDim.x, blockIdx.x);
        pg8::EpiResNorm<false> E{a.in[0], a.in[1], a.out, mod, 2048, 3072, 4096, a.in[9], XN, (float*)(ws + WS_SLOTS), (unsigned*)(ws + WS_CNT)};
        pg8::gemm_phase<pg8::EpiResNorm<false>, pg8::StaticOrder, true, true>(L, g, S, E); } SEAM(5);
    if (IN(6)) { PHASE_VARS pg8::Gemm g{XN, (const bf16_t*)(ws + WS_WUP), MP, FF2, D}; pg8::StaticOrder S; S.init(MP, FF2, gridDim.x, blockIdx.x);
        pg8::EpiPlain E{(bf16_t*)(ws + WS_U), FF2};
        pg8::gemm_phase<pg8::EpiPlain, pg8::StaticOrder, true, true>(L, g, S, E); } SEAM(6);
    if (IN(7)) { PHASE_VARS phase_conv_seq(a, L, (const bf16_t*)(ws + WS_U), (bf16_t*)(ws + WS_AFF)); } SEAM(7);
    if (IN(8)) { PHASE_VARS pg8::Gemm g{XN + (size_t)MP * D, (const bf16_t*)(ws + WS_WUP), MP, FF2, D}; pg8::StaticOrder S; S.init(MP, FF2, gridDim.x, blockIdx.x);
        pg8::EpiPlain E{(bf16_t*)(ws + WS_U), FF2};
        pg8::gemm_phase<pg8::EpiPlain, pg8::StaticOrder, true, true>(L, g, S, E); } SEAM(8);
    if (IN(9)) { PHASE_VARS phase_conv_grid4(a, L, (const bf16_t*)(ws + WS_U), (bf16_t*)(ws + WS_AFF) + (size_t)MP * FF); } SEAM(9);
    if (IN(10)) { PHASE_VARS pg8::Gemm g{(const bf16_t*)(ws + WS_AFF), (const bf16_t*)(ws + WS_WDN), MTOK, D, FF}; pg8::StaticOrder S; S.init(MTOK, D, gridDim.x, blockIdx.x);
        pg8::EpiResNorm<true> E{a.out, a.out + (size_t)MP * D, a.out, mod, 5120, 0, 0, a.in[21], nullptr, (float*)(ws + WS_SLOTS) + (size_t)MTOK * 4, (unsigned*)(ws + WS_CNT) + 64 * 64};
        pg8::gemm_phase<pg8::EpiResNorm<true>, pg8::StaticOrder, true, true>(L, g, S, E); } SEAM(10);
#undef IN
#undef SEAM
}

extern "C" void kernel_launch(void* const* d_in, const int* in_sizes, int n_in, void* d_out, int out_size, void* d_ws, size_t ws_size, hipStream_t stream) {
    static int grid = 0;
    if (grid == 0) {
        if (n_in != 22 || ws_size < WS_END) { fprintf(stderr, "kernel_launch: unexpected n_in %d / ws %zu\n", n_in, ws_size); grid = -1; return; }
        int dev = 0, cus = 0, per_cu = 0;
        (void)hipGetDevice(&dev); (void)hipDeviceGetAttribute(&cus, hipDeviceAttributeMultiprocessorCount, dev);
        if (hipFuncSetAttribute((const void*)fwd_mega, hipFuncAttributeMaxDynamicSharedMemorySize, LDS_BYTES) != hipSuccess) { fprintf(stderr, "hipFuncSetAttribute failed\n"); grid = -1; return; }
        if (hipOccupancyMaxActiveBlocksPerMultiprocessor(&per_cu, (const void*)fwd_mega, 512, LDS_BYTES) != hipSuccess || per_cu < 1) { fprintf(stderr, "occupancy query: %d\n", per_cu); grid = -1; return; }
        grid = cus;
        if (grid != 256) { fprintf(stderr, "kernel_launch: built for a 256-CU device (grid %d)\n", grid); grid = -1; return; }
    }
    if (grid < 0) return;
    if (hipMemsetAsync((char*)d_ws + WS_BAR, 0, 16384, stream) != hipSuccess) { fprintf(stderr, "kernel_launch: hipMemsetAsync failed\n"); return; }
    Args a{};
    for (int i = 0; i < 22; ++i) a.in[i] = (const float*)d_in[i];
    a.out = (float*)d_out; a.ws = (unsigned char*)d_ws;
#if MK_MULTI
    for (int p = 0; p < NPH; ++p) { a.ph_lo = p; a.ph_hi = p + 1; hipLaunchKernelGGL(fwd_mega, dim3(grid), dim3(512), LDS_BYTES, stream, a); }
#else
    a.ph_lo = 0; a.ph_hi = NPH;
    void* args[] = {&a};
    hipError_t e = hipLaunchCooperativeKernel((const void*)fwd_mega, dim3(grid), dim3(512), args, LDS_BYTES, stream);
    if (e != hipSuccess) fprintf(stderr, "cooperative launch failed: %s (grid %d)\n", hipGetErrorString(e), grid);
#endif
}
```

```cpp
#include <hip/hip_runtime.h>
#include <hip/hip_cooperative_groups.h>
#include <cstdio>
#include <cstdint>
namespace cg = cooperative_groups;
#ifndef MK_MULTI
#define MK_MULTI 0
#endif
namespace pg8 {
#define PG8_LAS __attribute__((address_space(3)))
typedef unsigned short bf16_t;
typedef short bf16x8 __attribute__((ext_vector_type(8)));
typedef float f32x4 __attribute__((ext_vector_type(4)));
typedef unsigned u32x4 __attribute__((ext_vector_type(4)));
typedef unsigned u32x2 __attribute__((ext_vector_type(2)));
constexpr int BM = 256, BK = 64, HALF = 128, HTB = HALF * BK * 2  , STAGE_BYTES = 8 * HTB, NXCD = 8, WGM = 8;

__host__ __device__ __forceinline__ int lds_byte(int r, int c) { const int st = (r >> 4) * 2 + (c >> 5), rr = r & 15, cc = c & 31, ob = rr * 64 + cc * 2; return st * 1024 + (ob ^ (((ob >> 9) & 1) << 5)); }
__host__ __device__ __forceinline__ void stage_rc(int b, int& R, int& C) { const int st = b / 1024, sb = b % 1024, swz = sb ^ (((sb >> 9) & 1) << 5); R = (st >> 1) * 16 + swz / 64; C = (st & 1) * 32 + (swz % 64) / 2; }
__host__ __device__ __forceinline__ int perm32(int rho) { const int n = rho >> 4, i = rho & 15; return 8 * (i >> 2) + 4 * n + (i & 3); }

struct Unit { int pm, pn; };
struct Gemm { const bf16_t* A; const bf16_t* Bt; int M, N, K; };

struct StaticOrder {
    int nM, nN, nwg, G, c;
    __host__ __device__ void init(int M, int N, int G_, int c_) { nM = M / BM; nN = N / BM; nwg = nM * nN; G = G_; c = c_; }
    __host__ __device__ bool next(int i, Unit& u) const {
        const long L = (long)i * G + c; if (L >= nwg) return false;
        int wgid = (int)L; { const int q = nwg / NXCD, r = nwg % NXCD, xcd = wgid % NXCD, off = wgid / NXCD; wgid = (xcd < r ? xcd * (q + 1) : r * (q + 1) + (xcd - r) * q) + off; }
        const int nig = WGM * nN, gid = wgid / nig, fm = gid * WGM, gsz = (nM - fm) < WGM ? (nM - fm) : WGM;
        u.pm = fm + ((wgid % nig) % gsz); u.pn = (wgid % nig) / gsz; return true;
    }
    __device__ __forceinline__ void a_ready(const Unit&) const {}
    __device__ __forceinline__ void done(const Unit&) const {}
};

__device__ __forceinline__ unsigned cvt_pk_bf16(float lo, float hi) { unsigned r; asm volatile("v_cvt_pk_bf16_f32 %0, %1, %2" : "=v"(r) : "v"(lo), "v"(hi)); return r; }
typedef float f32x2 __attribute__((ext_vector_type(2)));
typedef float f32x2_t __attribute__((ext_vector_type(2))); typedef __bf16 bf16x2_t __attribute__((ext_vector_type(2)));
__device__ __forceinline__ unsigned cvtpk(float lo, float hi) { f32x2_t v = {lo, hi}; bf16x2_t b = __builtin_convertvector(v, bf16x2_t); return __builtin_bit_cast(unsigned, b); }
__device__ __forceinline__ float fast_exp(float x) { return __builtin_amdgcn_exp2f(x * 1.4426950408889634f); }
__device__ __forceinline__ float fast_log(float x) { return __builtin_amdgcn_logf(x) * 0.6931471805599453f; }
__device__ __forceinline__ float fast_rcp(float x) { return __builtin_amdgcn_rcpf(x); }
__device__ __forceinline__ float silu_f(float x) { return x * fast_rcp(1.f + fast_exp(-x)); }

struct EpiPlain {
    static constexpr bool PERM = true, AFTER_DRAIN = false;
    bf16_t* O; int ldc;
    __device__ __forceinline__ void operator()(const f32x4 (&acc)[2][2][4][2], const Unit& u, int wr, int wc, int fr, int fq) const {
        const int row0 = u.pm * BM + wr * 64 + fr, col0 = u.pn * BM + wc * 32 + 8 * fq;
#pragma unroll
        for (int ai = 0; ai < 2; ++ai)
#pragma unroll
            for (int m = 0; m < 4; ++m) { bf16_t* rowp = O + (size_t)(row0 + ai * HALF + m * 16) * ldc + col0;
#pragma unroll
                for (int bj = 0; bj < 2; ++bj) { const f32x4 v0 = acc[ai][bj][m][0], v1 = acc[ai][bj][m][1];
                    u32x4 w; w.x = cvtpk(v0[0], v0[1]); w.y = cvtpk(v0[2], v0[3]); w.z = cvtpk(v1[0], v1[1]); w.w = cvtpk(v1[2], v1[3]);
                    *(u32x4*)(rowp + bj * HALF) = w; } }
    }
};
struct EpiProj {
    static constexpr bool PERM = true, AFTER_DRAIN = false;
    bf16_t* O; const float* c0; const float* c1;
    __device__ __forceinline__ void operator()(const f32x4 (&acc)[2][2][4][2], const Unit& u, int wr, int wc, int fr, int fq) const {
        const int row0 = u.pm * BM + wr * 64 + fr; const int pn = u.pn;
        const int kind = (pn == 0) ? 1 : ((pn == 4 || pn == 5 || pn == 14 || pn == 15) ? 2 : ((pn >= 8 && pn <= 11) ? 3 : (pn >= 16 ? 4 : 0)));
#pragma unroll
        for (int bj = 0; bj < 2; ++bj) {
            const int col = pn * BM + bj * HALF + wc * 32 + 8 * fq;
            f32x4 ca0 = {0.f, 0.f, 0.f, 0.f}, ca1 = ca0, cb0 = ca0, cb1 = ca0;
            if (kind >= 3) { ca0 = *(const f32x4*)(c0 + col); ca1 = *(const f32x4*)(c0 + col + 4); }
            if (kind == 3) { cb0 = *(const f32x4*)(c1 + col); cb1 = *(const f32x4*)(c1 + col + 4); }
#pragma unroll
            for (int ai = 0; ai < 2; ++ai)
#pragma unroll
                for (int m = 0; m < 4; ++m) {
                    f32x4 v0 = acc[ai][bj][m][0], v1 = acc[ai][bj][m][1];
                    if (kind == 1) { v0 = v0 * 0.125f; v1 = v1 * 0.125f; }
                    else if (kind == 2) {
#pragma unroll
                        for (int e = 0; e < 4; ++e) { v0[e] = silu_f(v0[e]); v1[e] = silu_f(v1[e]); } }
                    else if (kind == 3) {
#pragma unroll
                        for (int e = 0; e < 4; ++e) { v0[e] = fast_log(ca0[e] + cb0[e] * fast_rcp(1.f + fast_exp(-v0[e]))); v1[e] = fast_log(ca1[e] + cb1[e] * fast_rcp(1.f + fast_exp(-v1[e]))); } }
                    else if (kind == 4) {
#pragma unroll
                        for (int e = 0; e < 4; ++e) { v0[e] = -0.0625f * fast_log(1.f + fast_exp(-(v0[e] + ca0[e]))); v1[e] = -0.0625f * fast_log(1.f + fast_exp(-(v1[e] + ca1[e]))); } }
                    u32x4 w; w.x = cvtpk(v0[0], v0[1]); w.y = cvtpk(v0[2], v0[3]); w.z = cvtpk(v1[0], v1[1]); w.w = cvtpk(v1[2], v1[3]);
                    *(u32x4*)(O + (size_t)(row0 + ai * HALF + m * 16) * 4608 + col) = w;
                }
        }
    }
};
struct EpiRes {
    static constexpr bool PERM = false, AFTER_DRAIN = false;
    const float* base0; const float* base1; float* out; const float* gate;
    __device__ __forceinline__ void operator()(const f32x4 (&acc)[2][2][4][2], const Unit& u, int wr, int wc, int fr, int fq) const {
        const int rt = u.pm * BM;
        const float* base = rt < 8192 ? base0 + (size_t)rt * 1024 : base1 + (size_t)(rt - 8192) * 1024;
        const float* g = gate + (rt < 8192 ? 0 : 1 + ((rt - 8192) >> 11)) * 6144;
        float* o = out + (size_t)rt * 1024;
        const int col0 = u.pn * BM + wc * 32 + 4 * fq;
#pragma unroll
        for (int bj = 0; bj < 2; ++bj)
#pragma unroll
            for (int n = 0; n < 2; ++n) { const int col = col0 + bj * HALF + n * 16; const f32x4 g4 = *(const f32x4*)(g + col);
#pragma unroll
                for (int ai = 0; ai < 2; ++ai)
#pragma unroll
                    for (int m = 0; m < 4; ++m) { const size_t off = (size_t)(ai * HALF + wr * 64 + m * 16 + fr) * 1024 + col;
                        const f32x4 b = *(const f32x4*)(base + off); *(f32x4*)(o + off) = b + g4 * acc[ai][bj][m][n]; } }
    }
};

template <bool FINAL> struct EpiResNorm {
    static constexpr bool PERM = false, AFTER_DRAIN = true;
    static constexpr int LROW = 260;
    const float* base0; const float* base1; float* out; const float* mod; int gate_off, shift_off, scale_off; const float* gvec; bf16_t* XN; float* slots; unsigned* cnt;
    __device__ __forceinline__ void fused(f32x4 (&acc)[2][2][4][2], const Unit& u, int wr, int wc, int fr, int fq, PG8_LAS unsigned char* lds, int wid, int lane) const {
        const int rt = u.pm * BM;
        const float* base = rt < 8192 ? base0 + (size_t)rt * 1024 : base1 + (size_t)(rt - 8192) * 1024;
        const float* mv = mod + (rt < 8192 ? 0 : 1 + ((rt - 8192) >> 11)) * 6144;
        float* o = out + (size_t)rt * 1024;
        const int col0 = u.pn * BM + wc * 32 + 4 * fq;
        PG8_LAS float* T = (PG8_LAS float*)lds;
        PG8_LAS float* Pp = T + 128 * LROW; PG8_LAS float* Sr = Pp + 1024;
        const int lbase = (wr * 64 + fr) * LROW + wc * 32 + 4 * fq;
        float ss[2][4];
#pragma unroll
        for (int ai = 0; ai < 2; ++ai)
#pragma unroll
            for (int m = 0; m < 4; ++m) ss[ai][m] = 0.f;
#pragma unroll
        for (int bj = 0; bj < 2; ++bj)
#pragma unroll
            for (int n = 0; n < 2; ++n) { const int col = col0 + bj * HALF + n * 16; const f32x4 g4 = *(const f32x4*)(mv + gate_off + col);
                f32x4 bv[2][4];
#pragma unroll
                for (int ai = 0; ai < 2; ++ai)
#pragma unroll
                    for (int m = 0; m < 4; ++m) bv[ai][m] = *(const f32x4*)(base + (size_t)(ai * HALF + wr * 64 + m * 16 + fr) * 1024 + col);
#pragma unroll
                for (int ai = 0; ai < 2; ++ai)
#pragma unroll
                    for (int m = 0; m < 4; ++m) { const size_t off = (size_t)(ai * HALF + wr * 64 + m * 16 + fr) * 1024 + col;
                        const f32x4 v = bv[ai][m] + g4 * acc[ai][bj][m][n];
                        if (!FINAL) __builtin_nontemporal_store(v, (f32x4*)(o + off));
                        ss[ai][m] += (v[0] * v[0] + v[1] * v[1]) + (v[2] * v[2] + v[3] * v[3]);
                        if (ai == 0) *(PG8_LAS f32x4*)(T + lbase + m * 16 * LROW + bj * HALF + n * 16) = v; else acc[1][bj][m][n] = v; } }
#pragma unroll
        for (int ai = 0; ai < 2; ++ai)
#pragma unroll
            for (int m = 0; m < 4; ++m) { float s = ss[ai][m]; s += __shfl_xor(s, 16); s += __shfl_xor(s, 32);
                if (fq == 0) Pp[(ai * HALF + wr * 64 + m * 16 + fr) * 4 + wc] = s; }
        __syncthreads();
        const int tid = wid * 64 + lane;
        if (tid < 256) { const f32x4 p = *(const PG8_LAS f32x4*)(Pp + tid * 4);
            __hip_atomic_store(slots + (size_t)(rt + tid) * 4 + u.pn, (p[0] + p[1]) + (p[2] + p[3]), __ATOMIC_RELAXED, __HIP_MEMORY_SCOPE_AGENT); }
        asm volatile("s_waitcnt vmcnt(0)" ::: "memory");
        __syncthreads();
        if (tid == 0) { unsigned* c = cnt + 64 * u.pm; __hip_atomic_fetch_add(c, 1u, __ATOMIC_RELAXED, __HIP_MEMORY_SCOPE_AGENT);
            for (unsigned sp = 0; sp < (1u << 24); ++sp) { if (__hip_atomic_load(c, __ATOMIC_RELAXED, __HIP_MEMORY_SCOPE_AGENT) >= 4u) break; __builtin_amdgcn_s_sleep(1); } }
        __syncthreads();
        if (tid < 256) { float t = 0.f;
#pragma unroll
            for (int q = 0; q < 4; ++q) t += __hip_atomic_load(slots + (size_t)(rt + tid) * 4 + q, __ATOMIC_RELAXED, __HIP_MEMORY_SCOPE_AGENT);
            Sr[tid] = rsqrtf(t * (1.f / 1024.f) + 1e-6f); }
        __syncthreads();
#pragma unroll
        for (int bj = 0; bj < 2; ++bj)
#pragma unroll
            for (int n = 0; n < 2; ++n) { const int col = col0 + bj * HALF + n * 16; const f32x4 gg = *(const f32x4*)(gvec + col);
                f32x4 sc = {0.f, 0.f, 0.f, 0.f}, sh = sc; if (!FINAL) { sc = *(const f32x4*)(mv + scale_off + col) + 1.f; sh = *(const f32x4*)(mv + shift_off + col); }
#pragma unroll
                for (int ai = 0; ai < 2; ++ai)
#pragma unroll
                    for (int m = 0; m < 4; ++m) { const int r = ai * HALF + wr * 64 + m * 16 + fr; const float rs = Sr[r];
                        const f32x4 v = ai == 0 ? *(const PG8_LAS f32x4*)(T + lbase + m * 16 * LROW + bj * HALF + n * 16) : acc[1][bj][m][n];
                        if (FINAL) __builtin_nontemporal_store(v * rs * gg, (f32x4*)(o + (size_t)r * 1024 + col));
                        else { const f32x4 h = v * rs * gg * sc + sh; u32x2 w; w.x = cvtpk(h[0], h[1]); w.y = cvtpk(h[2], h[3]); *(u32x2*)(XN + (size_t)(rt + r) * 1024 + col) = w; } } }
    }
};
template <class Epi, class Sched, bool ALIGN_EPI = false, bool SP2 = false>
__device__ __forceinline__ void gemm_phase(PG8_LAS unsigned char* lds, const Gemm g, const Sched& S, const Epi& E) {
    const int tid = threadIdx.x, wid = __builtin_amdgcn_readfirstlane(tid >> 6), lane = tid & 63, wr = wid >> 2, wc = wid & 3, fr = lane & 15, fq = lane >> 4;
    const int K = g.K, nt = K / BK;
    unsigned voffA[2], voffB[2];
#pragma unroll
    for (int i = 0; i < 2; ++i) { int R, C; stage_rc(tid * 16 + i * 8192, R, C); const int Rb = Epi::PERM ? ((R & ~31) + perm32(R & 31)) : R;
        voffA[i] = (unsigned)(R * K + C) * 2u; voffB[i] = (unsigned)(Rb * K + C) * 2u; }
    const size_t kstep = (size_t)(BK * 2);
    const size_t hstep = (size_t)HALF * K * 2;
    const size_t tstep = 2 * hstep;
    const unsigned ldsw = (unsigned)wid * 1024u;
    const int aoff = lds_byte(wr * 64 + fr, fq * 8), boff = lds_byte(wc * 32 + fr, fq * 8);
#define PG8_SA(b, h) (((b) * 2 + (h)) * HTB)
#define PG8_SB(b, h) ((4 + (b) * 2 + (h)) * HTB)
#define PG8_STAGE(bufoff, gbase, voff) do { _Pragma("unroll") for (int _i = 0; _i < 2; ++_i) \
        __builtin_amdgcn_global_load_lds((const unsigned*)((const char*)(gbase) + (voff)[_i]), (PG8_LAS unsigned*)(lds + (bufoff) + ldsw + _i * 8192), 16, 0, 0); } while (0)
#define PG8_LDA(dst, b, h) do { _Pragma("unroll") for (int m = 0; m < 4; ++m) _Pragma("unroll") for (int k = 0; k < 2; ++k) dst[m][k] = *(const PG8_LAS bf16x8*)(lds + PG8_SA(b, h) + aoff + m * 2048 + k * 1024); } while (0)
#define PG8_LDB(dst, b, h) do { _Pragma("unroll") for (int n = 0; n < 2; ++n) _Pragma("unroll") for (int k = 0; k < 2; ++k) dst[n][k] = *(const PG8_LAS bf16x8*)(lds + PG8_SB(b, h) + boff + n * 2048 + k * 1024); } while (0)
#define PG8_MMA(ai, bj, At, Bt) do { __builtin_amdgcn_s_setprio(1); _Pragma("unroll") for (int m = 0; m < 4; ++m) _Pragma("unroll") for (int n = 0; n < 2; ++n) _Pragma("unroll") for (int k = 0; k < 2; ++k) \
        acc[ai][bj][m][n] = __builtin_amdgcn_mfma_f32_16x16x32_bf16(Bt[n][k], At[m][k], acc[ai][bj][m][n], 0, 0, 0); __builtin_amdgcn_s_setprio(0); } while (0)
#define PG8_WAIT_V(n) asm volatile("s_waitcnt vmcnt(" #n ")" ::: "memory")
#define PG8_WAIT_L(n) asm volatile("s_waitcnt lgkmcnt(" #n ")" ::: "memory")
#define PG8_BAR __builtin_amdgcn_s_barrier()
#define PG8_SCHED __builtin_amdgcn_sched_barrier(0)
    Unit cur, nxt; int ui = 0;
    if (!S.next(0, cur)) return;
    f32x4 acc[2][2][4][2];
#pragma unroll
    for (int a = 0; a < 2; ++a)
#pragma unroll
        for (int b = 0; b < 2; ++b)
#pragma unroll
            for (int m = 0; m < 4; ++m)
#pragma unroll
                for (int n = 0; n < 2; ++n) acc[a][b][m][n] = (f32x4){0.f, 0.f, 0.f, 0.f};
    bf16x8 At[4][2], B0[2][2], B1[2][2];
    const char* cA = (const char*)g.A + (size_t)cur.pm * tstep; const char* cB = (const char*)g.Bt + (size_t)cur.pn * tstep;
    S.a_ready(cur);
    if constexpr (SP2) {
        PG8_STAGE(PG8_SB(0, 0), cB, voffB); PG8_STAGE(PG8_SB(0, 1), cB + hstep, voffB); PG8_STAGE(PG8_SA(0, 0), cA, voffA); PG8_STAGE(PG8_SA(0, 1), cA + hstep, voffA);
        if (wr == 1) PG8_BAR;
        PG8_WAIT_V(2); PG8_BAR;
        PG8_STAGE(PG8_SB(1, 0), cB + kstep, voffB); PG8_STAGE(PG8_SA(1, 0), cA + kstep, voffA); PG8_STAGE(PG8_SB(1, 1), cB + hstep + kstep, voffB);
        PG8_WAIT_V(6); PG8_BAR;
    } else {
        PG8_STAGE(PG8_SB(0, 0), cB, voffB); PG8_STAGE(PG8_SA(0, 0), cA, voffA); PG8_STAGE(PG8_SB(0, 1), cB + hstep, voffB); PG8_STAGE(PG8_SA(0, 1), cA + hstep, voffA);
        if (wr == 1) PG8_BAR;
        PG8_WAIT_V(4); PG8_BAR;
        PG8_STAGE(PG8_SB(1, 0), cB + kstep, voffB); PG8_STAGE(PG8_SA(1, 0), cA + kstep, voffA); PG8_STAGE(PG8_SB(1, 1), cB + hstep + kstep, voffB);
        PG8_WAIT_V(6); PG8_BAR;
    }
    for (;;) {
        const bool has_next = S.next(ui + 1, nxt);
        const char* nA = has_next ? (const char*)g.A + (size_t)nxt.pm * tstep : cA; const char* nB = has_next ? (const char*)g.Bt + (size_t)nxt.pn * tstep : cB;
        for (int t = 0; t < nt; t += 2) {
            const bool last = (t == nt - 2);
            const char* a1 = cA + (size_t)(t + 1) * kstep;
            const char* a2 = last ? nA : cA + (size_t)(t + 2) * kstep; const char* b2 = last ? nB : cB + (size_t)(t + 2) * kstep;
            const char* a3 = a2 + kstep; const char* b3 = b2 + kstep;
            if (last && has_next) S.a_ready(nxt);
            if constexpr (SP2) {
            PG8_LDB(B0, 0, 0); PG8_LDB(B1, 0, 1); PG8_SCHED; PG8_LDA(At, 0, 0); PG8_STAGE(PG8_SA(1, 1), a1 + hstep, voffA);
            PG8_WAIT_V(8); PG8_WAIT_L(0); PG8_BAR; PG8_MMA(0, 0, At, B0); PG8_MMA(0, 1, At, B1); PG8_BAR; PG8_SCHED;
            PG8_LDA(At, 0, 1); PG8_STAGE(PG8_SB(0, 0), b2, voffB); PG8_STAGE(PG8_SB(0, 1), b2 + hstep, voffB); PG8_STAGE(PG8_SA(0, 0), a2, voffA);
            PG8_WAIT_V(8); PG8_WAIT_L(0); PG8_BAR; PG8_MMA(1, 0, At, B0); PG8_MMA(1, 1, At, B1); PG8_BAR; PG8_SCHED;
            PG8_LDB(B0, 1, 0); PG8_LDB(B1, 1, 1); PG8_SCHED; PG8_LDA(At, 1, 0); PG8_STAGE(PG8_SA(0, 1), a2 + hstep, voffA);
            PG8_WAIT_V(8); PG8_WAIT_L(0); PG8_BAR; PG8_MMA(0, 0, At, B0); PG8_MMA(0, 1, At, B1); PG8_BAR; PG8_SCHED;
            PG8_LDA(At, 1, 1); PG8_STAGE(PG8_SB(1, 0), b3, voffB); PG8_STAGE(PG8_SB(1, 1), b3 + hstep, voffB); PG8_STAGE(PG8_SA(1, 0), a3, voffA);
            PG8_WAIT_V(8); PG8_WAIT_L(0); PG8_BAR; PG8_MMA(1, 0, At, B0); PG8_MMA(1, 1, At, B1); PG8_BAR; PG8_SCHED;
            } else {
            PG8_LDB(B0, 0, 0); PG8_SCHED; PG8_LDA(At, 0, 0); PG8_STAGE(PG8_SA(1, 1), a1 + hstep, voffA);
            PG8_WAIT_L(8); PG8_BAR; PG8_WAIT_L(0); PG8_MMA(0, 0, At, B0); PG8_BAR; PG8_SCHED;
            PG8_LDB(B1, 0, 1); PG8_STAGE(PG8_SB(0, 0), b2, voffB);
            PG8_BAR; PG8_WAIT_L(0); PG8_MMA(0, 1, At, B1); PG8_BAR;
            PG8_LDA(At, 0, 1); PG8_STAGE(PG8_SA(0, 0), a2, voffA);
            PG8_BAR; PG8_WAIT_L(0); PG8_MMA(1, 0, At, B0); PG8_BAR; PG8_SCHED;
            PG8_STAGE(PG8_SB(0, 1), b2 + hstep, voffB);
            PG8_WAIT_V(6); PG8_BAR; PG8_MMA(1, 1, At, B1); PG8_BAR;
            PG8_LDB(B0, 1, 0); PG8_SCHED; PG8_LDA(At, 1, 0); PG8_STAGE(PG8_SA(0, 1), a2 + hstep, voffA);
            PG8_WAIT_L(8); PG8_BAR; PG8_WAIT_L(0); PG8_MMA(0, 0, At, B0); PG8_BAR; PG8_SCHED;
            PG8_LDB(B1, 1, 1); PG8_STAGE(PG8_SB(1, 0), b3, voffB);
            PG8_BAR; PG8_WAIT_L(0); PG8_MMA(0, 1, At, B1); PG8_BAR;
            PG8_LDA(At, 1, 1); PG8_STAGE(PG8_SA(1, 0), a3, voffA);
            PG8_BAR; PG8_WAIT_L(0); PG8_MMA(1, 0, At, B0); PG8_BAR; PG8_SCHED;
            PG8_STAGE(PG8_SB(1, 1), b3 + hstep, voffB);
            PG8_WAIT_V(6); PG8_BAR; PG8_MMA(1, 1, At, B1); PG8_BAR;
            }
        }
        if constexpr (ALIGN_EPI) { if (wr == 0) PG8_BAR; }
        if constexpr (!Epi::AFTER_DRAIN) { E(acc, cur, wr, wc, fr, fq); S.done(cur); }
        if (!has_next) break;
#pragma unroll
        for (int a = 0; a < 2; ++a)
#pragma unroll
            for (int b = 0; b < 2; ++b)
#pragma unroll
                for (int m = 0; m < 4; ++m)
#pragma unroll
                    for (int n = 0; n < 2; ++n) acc[a][b][m][n] = (f32x4){0.f, 0.f, 0.f, 0.f};
        cur = nxt; cA = nA; cB = nB; ++ui;
        if constexpr (ALIGN_EPI) { if (wr == 1) PG8_BAR; }
    }
    PG8_WAIT_V(0);
    if constexpr (!ALIGN_EPI) { if (wr == 0) PG8_BAR; }
    PG8_BAR;
    if constexpr (Epi::AFTER_DRAIN) { E.fused(acc, cur, wr, wc, fr, fq, lds, wid, lane); S.done(cur); }
#undef PG8_SA
#undef PG8_SB
#undef PG8_STAGE
#undef PG8_LDA
#undef PG8_LDB
#undef PG8_MMA
#undef PG8_WAIT_V
#undef PG8_WAIT_L
#undef PG8_BAR
#undef PG8_SCHED
}
}
#define LAS __attribute__((address_space(3)))
typedef unsigned short bf16_t;
typedef float f32x4 __attribute__((ext_vector_type(4)));
typedef unsigned u32x4 __attribute__((ext_vector_type(4)));
typedef unsigned u32x2 __attribute__((ext_vector_type(2)));
typedef short bf16x8 __attribute__((ext_vector_type(8)));
typedef short s16x4 __attribute__((ext_vector_type(4)));
using pg8::f32x2_t; using pg8::cvtpk; using pg8::fast_exp; using pg8::fast_log; using pg8::fast_rcp; using pg8::silu_f;

constexpr int D = 1024, MTOK = 16384, MP = 8192, NP = 4608, FF = 2816, FF2 = 5632, INW = 4128, NMOD = 6144;
constexpr float EPS = 1e-6f;
constexpr size_t MiB = 1u << 20;
constexpr size_t WS_MOD = 0, WS_C0 = 256 * 1024, WS_C1 = 512 * 1024, WS_PART = 1 * MiB, WS_WIN = 2 * MiB, WS_WO = 11 * MiB, WS_WUP = 13 * MiB, WS_WDN = 24 * MiB,
                 WS_XN = 30 * MiB, WS_P = 62 * MiB, WS_U = 62 * MiB, WS_AFF = 150 * MiB, WS_END = 240 * MiB;
constexpr size_t WS_CNT = 768 * 1024, WS_SLOTS = 239 * MiB;
constexpr size_t WS_BAR = 832 * 1024;
constexpr int LDS_BYTES = 163840, LDS_MISC = 163840 - 64;
constexpr int NPH = 11;

__device__ __forceinline__ float bf_lo(unsigned u) { return __uint_as_float(u << 16); }
__device__ __forceinline__ float bf_hi(unsigned u) { return __uint_as_float(u & 0xffff0000u); }
__device__ __forceinline__ float wave_sum(float v) {
#pragma unroll
    for (int o = 1; o < 64; o <<= 1) v += __shfl_xor(v, o);
    return v;
}

struct Args { const float* in[22]; float* out; unsigned char* ws; int ph_lo, ph_hi; };

__device__ __forceinline__ void tr_store(bf16_t* WT, int K, int dst_row0, int k0, LAS float* scr, int lane) {
    asm volatile("s_waitcnt lgkmcnt(0)" ::: "memory");
    const int c = lane & 7;
#pragma unroll
    for (int j = 0; j < 4; ++j) { const int n = (lane >> 3) + 8 * j; const LAS float* s = scr + (8 * c) * 33 + n;
        u32x4 o; o.x = cvtpk(s[0 * 33], s[1 * 33]); o.y = cvtpk(s[2 * 33], s[3 * 33]); o.z = cvtpk(s[4 * 33], s[5 * 33]); o.w = cvtpk(s[6 * 33], s[7 * 33]);
        *(u32x4*)(WT + (size_t)(dst_row0 + n) * K + k0 + 8 * c) = o; }
    asm volatile("s_waitcnt lgkmcnt(0)" ::: "memory");
}
__device__ __forceinline__ void tr_item(const float* W, int ldw, int src_col0, bf16_t* WT, int K, int dst_row0, int k0, LAS float* scr, int lane) {
#pragma unroll 8
    for (int i = 0; i < 32; ++i) { const int kk = 2 * i + (lane >> 5); scr[kk * 33 + (lane & 31)] = W[(size_t)(k0 + kk) * ldw + src_col0 + (lane & 31)]; }
    tr_store(WT, K, dst_row0, k0, scr, lane);
}
__device__ __forceinline__ void tr_item_alpha(const float* Win, const float* Wup, bf16_t* WT, int nb, int k0, LAS float* scr, int lane) {
    const int n0 = 32 * nb, dir = n0 >> 8, kc = (n0 & 255) + (lane & 31);
    float up[16];
#pragma unroll
    for (int r = 0; r < 16; ++r) up[r] = Wup[(dir * 16 + r) * 256 + kc];
    for (int i = 0; i < 32; ++i) { const int kk = 2 * i + (lane >> 5); const f32x4* wr = (const f32x4*)(Win + (size_t)(k0 + kk) * INW + 1536 + dir * 16);
        float s = 0.f;
#pragma unroll
        for (int q = 0; q < 4; ++q) { const f32x4 w = wr[q]; s += w[0] * up[4 * q] + w[1] * up[4 * q + 1] + w[2] * up[4 * q + 2] + w[3] * up[4 * q + 3]; }
        scr[kk * 33 + (lane & 31)] = s; }
    tr_store(WT, 1024, 4096 + n0, k0, scr, lane);
}

__device__ __forceinline__ void phase_prep(const Args& a, LAS unsigned char* L) {
    const int tid = threadIdx.x, lane = tid & 63, wave = tid >> 6;
    LAS float* scr = (LAS float*)(L + wave * 8704);
    LAS float* sc = (LAS float*)(L + 8 * 8704);
    for (int i = tid; i < 5 * 1024; i += 512) { const int v = i >> 10, k = i & 1023; const float x = v == 0 ? a.in[5][k] : a.in[4][(v - 1) * 1024 + k]; sc[i] = x / (1.f + __expf(-x)); }
    __syncthreads();
    bf16_t* WinT = (bf16_t*)(a.ws + WS_WIN); bf16_t* WoT = (bf16_t*)(a.ws + WS_WO); bf16_t* WupT = (bf16_t*)(a.ws + WS_WUP); bf16_t* WdnT = (bf16_t*)(a.ws + WS_WDN);
    float* part = (float*)(a.ws + WS_PART);
    if (blockIdx.x == 0 && tid < 128) ((unsigned*)(a.ws + WS_CNT))[tid * 64] = 0u;
    const int gw = blockIdx.x * 8 + wave, NGW = gridDim.x * 8;
    constexpr int I_MOD = 96 * 8, I_IN = 16 * 128, I_AL = 16 * 16, I_O = 16 * 32, I_UP = 16 * 176, I_DN = 44 * 32;
    constexpr int NIT = I_MOD + I_IN + I_AL;
    for (int it = gw; it < NIT; it += NGW) {
        int r = it;
        if (r < I_MOD) {
            const int cb = r >> 3, ks = r & 7, col = 64 * cb + lane; const float* w = a.in[6] + (size_t)(128 * ks) * NMOD + col;
            float acc[5] = {0.f, 0.f, 0.f, 0.f, 0.f};
            for (int k = 0; k < 128; k += 16) { float wv[16];
#pragma unroll
                for (int j = 0; j < 16; ++j) wv[j] = w[(size_t)(k + j) * NMOD];
#pragma unroll
                for (int j = 0; j < 16; ++j)
#pragma unroll
                    for (int v = 0; v < 5; ++v) acc[v] += sc[v * 1024 + 128 * ks + k + j] * wv[j]; }
#pragma unroll
            for (int v = 0; v < 5; ++v) part[(size_t)(ks * 5 + v) * NMOD + col] = acc[v];
            continue; }
        r -= I_MOD;
        if (r < I_IN) { const int kb = r >> 7, nb = r & 127, n0 = 32 * nb; tr_item(a.in[10], INW, n0 + (n0 >= 1536 ? 32 : 0), WinT, 1024, n0, 64 * kb, scr, lane); continue; }
        r -= I_IN;
        tr_item_alpha(a.in[10], a.in[11], WinT, r & 15, 64 * (r >> 4), scr, lane);
    }
}
__device__ __forceinline__ void phase_prep_late(const Args& a, LAS unsigned char* L, int nb0) {
    const int tid = threadIdx.x, lane = tid & 63, wave = tid >> 6;
    LAS float* scr = (LAS float*)(L + wave * 8704);
    bf16_t* WoT = (bf16_t*)(a.ws + WS_WO); bf16_t* WupT = (bf16_t*)(a.ws + WS_WUP); bf16_t* WdnT = (bf16_t*)(a.ws + WS_WDN);
    constexpr int I_O = 16 * 32, I_UP = 16 * 176, I_DN = 44 * 32;
    const int gw = ((int)blockIdx.x - nb0) * 8 + wave, NGW = ((int)gridDim.x - nb0) * 8;
    for (int it = gw; it < I_O + I_UP + I_DN; it += NGW) {
        int r = it;
        if (r < I_O) { tr_item(a.in[16], 1024, 32 * (r & 31), WoT, 1024, 32 * (r & 31), 64 * (r >> 5), scr, lane); continue; }
        r -= I_O;
        if (r < I_UP) { const int kb = r / 176, nb = r % 176; tr_item(a.in[17], FF2, 32 * nb, WupT, 1024, 32 * nb, 64 * kb, scr, lane); continue; }
        r -= I_UP;
        { const int kb = r >> 5, nb = r & 31; tr_item(a.in[20], 1024, 32 * nb, WdnT, FF, 32 * nb, 64 * kb, scr, lane); }
    }
}
__device__ __forceinline__ void phase_modfin(const Args& a) {
    const int gt = blockIdx.x * 512 + threadIdx.x, NT = gridDim.x * 512;
    float* mod = (float*)(a.ws + WS_MOD); const float* part = (const float*)(a.ws + WS_PART);
    float* c0 = (float*)(a.ws + WS_C0); float* c1 = (float*)(a.ws + WS_C1);
    for (int i = gt; i < 5 * NMOD; i += NT) { const int v = i / NMOD, col = i % NMOD; float s = a.in[7][col];
#pragma unroll
        for (int ks = 0; ks < 8; ++ks) s += part[(size_t)(ks * 5 + v) * NMOD + col];
        mod[i] = s; }
    for (int i = gt; i < NP; i += NT) { float v0 = 0.f, v1 = 0.f;
        if (i >= 2048 && i < 3072) { const int j = i - 2048; const float a0 = a.in[13][j], a1 = a.in[13][1024 + j]; const float m = fmaxf(a0, a1);
            const float e0 = __expf(a0 - m), e1 = __expf(a1 - m), inv = 1.f / (e0 + e1); v0 = e0 * inv; v1 = e1 * inv; }
        else if (i >= 4096) v0 = a.in[12][i - 4096];
        c0[i] = v0; c1[i] = v1; }
}
__device__ __forceinline__ void phase_norm1(const Args& a, LAS unsigned char* L, bf16_t* XN) {
    phase_modfin(a);
    const int tid = threadIdx.x, lane = tid & 63, wave = tid >> 6;
    const int rbase = blockIdx.x * (MTOK / 256);
    const int mi = rbase < MP ? 0 : 1 + ((rbase - MP) >> 11);
    LAS float* lm = (LAS float*)L;
    const float* part = (const float*)(a.ws + WS_PART);
    __syncthreads();
#pragma unroll
    for (int j = 0; j < 4; ++j) { const int col = tid + 512 * j; float sacc = a.in[7][col];
#pragma unroll
        for (int ks = 0; ks < 8; ++ks) sacc += part[(size_t)(ks * 5 + mi) * NMOD + col];
        lm[col] = sacc; }
    __syncthreads();
    const float* g = a.in[8];
    for (int r = wave; r < MTOK / 256; r += 8) {
        const int row = rbase + r;
        const float* xr = row < MP ? a.in[0] + (size_t)row * D : a.in[1] + (size_t)(row - MP) * D;
        f32x4 v[4]; float sq = 0.f;
#pragma unroll
        for (int j = 0; j < 4; ++j) { v[j] = *(const f32x4*)(xr + 4 * lane + 256 * j); sq += (v[j][0] * v[j][0] + v[j][1] * v[j][1]) + (v[j][2] * v[j][2] + v[j][3] * v[j][3]); }
        const float rstd = rsqrtf(wave_sum(sq) * (1.f / D) + EPS);
#pragma unroll
        for (int j = 0; j < 4; ++j) { const int c = 4 * lane + 256 * j; const f32x4 gg = *(const f32x4*)(g + c), sc = *(const LAS f32x4*)(lm + 1024 + c), sh = *(const LAS f32x4*)(lm + c);
            const f32x4 h = v[j] * rstd * gg * (sc + 1.f) + sh; u32x2 o; o.x = cvtpk(h[0], h[1]); o.y = cvtpk(h[2], h[3]);
            *(u32x2*)(XN + (size_t)row * D + c) = o; }
    }
}
__device__ __forceinline__ void phase_final_norm(float* y, const float* g) {
    const int lane = threadIdx.x & 63, gw = blockIdx.x * 8 + (threadIdx.x >> 6), NGW = gridDim.x * 8;
    for (int row = gw; row < MTOK; row += NGW) {
        float* xr = y + (size_t)row * D; f32x4 v[4]; float s = 0.f;
#pragma unroll
        for (int j = 0; j < 4; ++j) { v[j] = *(const f32x4*)(xr + 4 * lane + 256 * j); s += (v[j][0] * v[j][0] + v[j][1] * v[j][1]) + (v[j][2] * v[j][2] + v[j][3] * v[j][3]); }
        const float rstd = rsqrtf(wave_sum(s) * (1.f / D) + EPS);
#pragma unroll
        for (int j = 0; j < 4; ++j) { const int c = 4 * lane + 256 * j; const f32x4 gg = *(const f32x4*)(g + c); *(f32x4*)(xr + c) = v[j] * rstd * gg; }
    }
}

constexpr size_t WS_SLOC = 206 * MiB, WS_DTOT = 238 * MiB;
static_assert(WS_P + (size_t)MTOK * NP * 2 <= WS_SLOC && WS_DTOT + 256 * 1024 <= 239 * MiB, "ws map");
template <int DK> struct ScanCfg {
    static constexpr int SA = DK == 128 ? 272 : 144, SV = 288;
    static constexpr int OFF_A = 0, OFF_B = 64 * SA, OFF_K = 128 * SA, OFF_V = 192 * SA, OFF_F = OFF_V + 64 * SV, OFF_R = OFF_F + 4 * DK * 4, OFF_L = OFF_R + 64 * 8 * 4, END = OFF_L + 64 * SA;
    static constexpr int OPITCH = 264, OFF_O = END;
    static_assert(OFF_O + 256 * OPITCH <= 163840 - 64, "LDS");
    static constexpr int NPAIR = DK / 2;
    static constexpr int NR = DK / 16, NK = DK / 32;
};
__device__ __forceinline__ s16x4 vtr(const LAS unsigned char* p) { return __builtin_bit_cast(s16x4, __builtin_amdgcn_ds_read_tr16_b64_v4i16((LAS s16x4*)p)); }

template <int DK, bool HG>
__device__ __forceinline__ void scan_load(u32x4 (&R)[HG ? 6 : 5], const bf16_t* P, int row0, int T, int dir, int sc, int qcol, int kcol, int lfcol, int vcol, int tid) {
    const bf16_t* pb = P + (size_t)(row0 + (dir ? T - 1 - 64 * sc : 64 * sc)) * NP;
#pragma unroll
    for (int j = 0; j < (HG ? 6 : 5); ++j) {
        int tl, col;
        if (HG) { const int p = (tid + 512 * j) & 1023; tl = p >> 4; col = (j < 2 ? qcol : (j < 4 ? lfcol : vcol)) + 8 * (p & 15); }
        else if (j < 3) { tl = tid >> 3; col = (j == 0 ? qcol : (j == 1 ? kcol : lfcol)) + 8 * (tid & 7); }
        else { const int p = tid + 512 * (j - 3); tl = p >> 4; col = vcol + 8 * (p & 15); }
        R[j] = *(const u32x4*)(pb + (dir ? -tl : tl) * NP + col);
    }
}
template <int DK, bool HG>
__device__ __forceinline__ void scan_stash(const u32x4 (&R)[HG ? 6 : 5], LAS unsigned char* L, int tid) {
    using C = ScanCfg<DK>;
#pragma unroll
    for (int j = 0; j < (HG ? 6 : 5); ++j) {
        int off;
        if (HG) { const int p = (tid + 512 * j) & 1023; const int tl = p >> 4, ch = p & 15; off = (j < 2 ? C::OFF_A + tl * C::SA : (j < 4 ? C::OFF_L + tl * C::SA : C::OFF_V + tl * C::SV)) + ch * 16; }
        else if (j < 3) { off = (j == 0 ? C::OFF_A : (j == 1 ? C::OFF_B : C::OFF_L)) + (tid >> 3) * C::SA + (tid & 7) * 16; }
        else { const int p = tid + 512 * (j - 3); off = C::OFF_V + (p >> 4) * C::SV + (p & 15) * 16; }
        *(LAS u32x4*)(L + off) = R[j];
    }
}
template <int DK, bool HG, bool LIGHT>
__device__ __forceinline__ void scan_item(LAS unsigned char* L, const bf16_t* P, float* OF, bf16_t* XN, int row0, int T,
                                          int qcol, int kcol, int lfcol_f, int lfcol_b, int vcol, int sgcol, int mcol,
                                          const float* s0f, const float* s0b, const float* cmb_s, const float* cmb_d, int seg, float* sof, float* sob, float* dtot, const float* gnorm) {
    using C = ScanCfg<DK>;
    const int tid = threadIdx.x, lane = tid & 63, wid = tid >> 6, fr = lane & 15, fq = lane >> 4, cb = wid * 16;
    const int nsc = T >> 6;
    const float gn = LIGHT ? 0.f : gnorm[cb + fr];
    for (int dir = 0; dir < 2; ++dir) {
        f32x4 S[C::NR], Dacc[LIGHT ? C::NR : 1];
        { const float* s0 = dir ? s0b : s0f;
#pragma unroll
          for (int r = 0; r < C::NR; ++r) { if (LIGHT) Dacc[r] = (f32x4){1.f, 1.f, 1.f, 1.f};
#pragma unroll
              for (int jj = 0; jj < 4; ++jj) S[r][jj] = s0 ? s0[(16 * r + fq * 4 + jj) * 128 + cb + fr] : 0.f; }
          if (cmb_s) {
              const int n = dir ? 7 - seg : seg;
              for (int q = 0; q < n; ++q) { const int sj = dir ? 7 - q : q;
                  const float* sl = cmb_s + (size_t)(sj * 2 + dir) * 16384; const float* dl = cmb_d + (size_t)(sj * 2 + dir) * 128;
#pragma unroll
                  for (int r = 0; r < C::NR; ++r) { const f32x4 dd = *(const f32x4*)(dl + 16 * r + fq * 4);
#pragma unroll
                      for (int jj = 0; jj < 4; ++jj) S[r][jj] = S[r][jj] * dd[jj] + sl[(16 * r + fq * 4 + jj) * 128 + cb + fr]; } } } }
        const int lfcol = dir ? lfcol_b : lfcol_f;
        u32x4 R[HG ? 6 : 5];
        scan_load<DK, HG>(R, P, row0, T, dir, 0, qcol, kcol, lfcol, vcol, tid);
#pragma unroll 1
        for (int sc = 0; sc < nsc; ++sc) {
            int tid_o = tid; asm volatile("" : "+v"(tid_o));
            const int fr_o = tid_o & 15, fq_o = (tid_o >> 4) & 3, cb_o = (tid_o >> 6) << 4;
            __syncthreads();
            scan_stash<DK, HG>(R, L, tid_o);
            if (sc + 1 < nsc) scan_load<DK, HG>(R, P, row0, T, dir, sc + 1, qcol, kcol, lfcol, vcol, tid_o);
            __syncthreads();
            if (tid < 8 * C::NPAIR) {
                const int c = tid / (2 * C::NPAIR), rem = tid % (2 * C::NPAIR), half = rem / C::NPAIR, d0 = 2 * (rem % C::NPAIR);
                unsigned lfv[16];
#pragma unroll
                for (int i = 0; i < 16; ++i) lfv[i] = *(const LAS unsigned*)(L + C::OFF_L + (16 * c + i) * C::SA + d0 * 2);
                float h00 = 0.f, h01 = 0.f, h10 = 0.f, h11 = 0.f;
#pragma unroll
                for (int i = 0; i < 8; ++i) { h00 += bf_lo(lfv[i]); h01 += bf_hi(lfv[i]); h10 += bf_lo(lfv[8 + i]); h11 += bf_hi(lfv[8 + i]); }
                const float bl0 = fmaxf(h00 + h10, -80.f), bl1 = fmaxf(h01 + h11, -80.f);
                const float f0 = fast_exp(bl0), f1 = fast_exp(bl1);
                if (half == 0) *(LAS f32x2_t*)(L + C::OFF_F + (c * DK + d0) * 4) = (f32x2_t){f0, f1};
                const unsigned hmask = 0u - (unsigned)half;
                float s0 = half ? h00 : 0.f, s1 = half ? h01 : 0.f;
#pragma unroll
                for (int i = 0; i < 8; ++i) {
                    const unsigned lu = lfv[i] ^ ((lfv[i] ^ lfv[8 + i]) & hmask);
                    s0 += bf_lo(lu); s1 += bf_hi(lu);
                    const float b0 = fmaxf(s0, -80.f), b1 = fmaxf(s1, -80.f);
                    const int o = (16 * c + 8 * half + i) * C::SA + d0 * 2;
                    float k0, k1;
                    if (HG) { k0 = 1.f - fast_exp(bf_lo(lu)); k1 = 1.f - fast_exp(bf_hi(lu)); }
                    else { const unsigned ku = *(const LAS unsigned*)(L + C::OFF_B + o); k0 = bf_lo(ku); k1 = bf_hi(ku); }
                    const float bq0 = k0 * fast_exp(-b0), bq1 = k1 * fast_exp(-b1);
                    if (!LIGHT) {
                        const unsigned qu = *(const LAS unsigned*)(L + C::OFF_A + o);
                        *(LAS unsigned*)(L + C::OFF_A + o) = cvtpk(bf_lo(qu) * fast_exp(b0), bf_hi(qu) * fast_exp(b1));
                        *(LAS unsigned*)(L + C::OFF_B + o) = cvtpk(bq0, bq1);
                    }
                    *(LAS unsigned*)(L + C::OFF_K + o) = cvtpk(bq0 * f0, bq1 * f1);
                }
            }
            __syncthreads();
            f32x4 obuf[4];
            LAS unsigned short* ol = (LAS unsigned short*)(L + C::OFF_O) + (dir ? 255 - 64 * sc - fq * 4 : 64 * sc + fq * 4) * (C::OPITCH / 2) + cb + fr;
#pragma unroll
            for (int c = 0; c < 4; ++c) {
                const s16x4 vb = vtr(L + C::OFF_V + (16 * c + fq * 4 + (fr >> 2)) * C::SV + (cb + 4 * (fr & 3)) * 2);
                f32x4 o = {0.f, 0.f, 0.f, 0.f};
                if (!LIGHT) {
                bf16x8 a1[C::NK], b1[C::NK];
                const LAS unsigned char* pa = L + C::OFF_A + (16 * c + fr) * C::SA + fq * 8;
                const LAS unsigned char* pb = L + C::OFF_B + (16 * c + fr) * C::SA + fq * 8;
#pragma unroll
                for (int kk = 0; kk < C::NK; ++kk) {
                    const s16x4 al = *(const LAS s16x4*)(pa + kk * 64), ah = *(const LAS s16x4*)(pa + kk * 64 + 32);
                    const s16x4 bl = *(const LAS s16x4*)(pb + kk * 64), bh = *(const LAS s16x4*)(pb + kk * 64 + 32);
                    a1[kk] = (bf16x8){al[0], al[1], al[2], al[3], ah[0], ah[1], ah[2], ah[3]};
                    b1[kk] = (bf16x8){bl[0], bl[1], bl[2], bl[3], bh[0], bh[1], bh[2], bh[3]};
                }
                f32x4 sT = {0.f, 0.f, 0.f, 0.f};
#pragma unroll
                for (int kk = 0; kk < C::NK; ++kk) sT = __builtin_amdgcn_mfma_f32_16x16x32_bf16(b1[kk], a1[kk], sT, 0, 0, 0);
#pragma unroll
                for (int jj = 0; jj < 4; ++jj) sT[jj] = (fq * 4 + jj <= fr) ? sT[jj] : 0.f;
                const unsigned p01 = cvtpk(sT[0], sT[1]), p23 = cvtpk(sT[2], sT[3]);
                const s16x4 pfrag = __builtin_bit_cast(s16x4, (u32x2){p01, p23});
                o = __builtin_amdgcn_mfma_f32_16x16x16bf16_1k(pfrag, vb, (f32x4){0.f, 0.f, 0.f, 0.f}, 0, 0, 0);
#pragma unroll
                for (int kk = 0; kk < C::NK; ++kk) {
                    const u32x4 sw = {cvtpk(S[2 * kk][0], S[2 * kk][1]), cvtpk(S[2 * kk][2], S[2 * kk][3]), cvtpk(S[2 * kk + 1][0], S[2 * kk + 1][1]), cvtpk(S[2 * kk + 1][2], S[2 * kk + 1][3])};
                    o = __builtin_amdgcn_mfma_f32_16x16x32_bf16(a1[kk], __builtin_bit_cast(bf16x8, sw), o, 0, 0, 0);
                }
                }
#pragma unroll
                for (int r = 0; r < C::NR; ++r) {
                    const f32x4 fc = *(const LAS f32x4*)(L + C::OFF_F + (c * DK + 16 * r + fq * 4) * 4);
                    const s16x4 ka = vtr(L + C::OFF_K + (16 * c + fq * 4 + (fr >> 2)) * C::SA + (16 * r + 4 * (fr & 3)) * 2);
                    S[r] = __builtin_amdgcn_mfma_f32_16x16x16bf16_1k(ka, vb, S[r] * fc, 0, 0, 0);
                    if (LIGHT) Dacc[r] = Dacc[r] * fc;
                }
#pragma unroll
                for (int jj = 0; jj < 4; ++jj) { if (LIGHT) continue;
                    if (dir == 0) ol[(16 * c + jj) * (C::OPITCH / 2)] = (unsigned short)(cvtpk(o[jj], o[jj]) & 0xffffu); else o[jj] += __uint_as_float((unsigned)ol[-(16 * c + jj) * (C::OPITCH / 2)] << 16); }
                obuf[c] = o;
            }
            if (!LIGHT && dir == 1) {
                unsigned sgp[4][2];
                { const bf16_t* gb = P + (size_t)(row0 + T - 1 - 64 * sc - fq_o * 4) * NP + sgcol + cb_o + fr_o;
#pragma unroll
                  for (int c = 0; c < 4; ++c)
#pragma unroll
                      for (int jj = 0; jj < 4; ++jj) { const unsigned sv = gb[-(16 * c + jj) * NP]; if (jj & 1) sgp[c][jj >> 1] |= sv << 16; else sgp[c][jj >> 1] = sv; } }
#pragma unroll
                for (int c = 0; c < 4; ++c)
#pragma unroll
                    for (int jj = 0; jj < 4; ++jj) { float ss = obuf[c][jj] * obuf[c][jj]; ss += __shfl_xor(ss, 1); ss += __shfl_xor(ss, 2); ss += __shfl_xor(ss, 4); ss += __shfl_xor(ss, 8);
                        if (fr == 0) *(LAS float*)(L + C::OFF_R + ((16 * c + fq * 4 + jj) * 8 + wid) * 4) = ss; }
                __syncthreads();
                bf16_t* xo = XN + (size_t)(row0 + T - 1 - 64 * sc - fq_o * 4) * D + mcol + cb_o + fr_o;
#pragma unroll
                for (int c = 0; c < 4; ++c)
#pragma unroll
                    for (int jj = 0; jj < 4; ++jj) { const int tl = 16 * c + fq * 4 + jj; const f32x4 r0 = *(const LAS f32x4*)(L + C::OFF_R + tl * 32), r1 = *(const LAS f32x4*)(L + C::OFF_R + tl * 32 + 16);
                        const float tot = ((r0[0] + r0[1]) + (r0[2] + r0[3])) + ((r1[0] + r1[1]) + (r1[2] + r1[3]));
                        const float rstd = rsqrtf(tot * (1.f / 128.f) + EPS);
                        const float sg = (jj & 1) ? bf_hi(sgp[c][jj >> 1]) : bf_lo(sgp[c][jj >> 1]);
                        const float val = obuf[c][jj] * rstd * gn * sg;
                        xo[-(16 * c + jj) * D] = (bf16_t)(cvtpk(val, val) & 0xffffu); }
            }
        }
        float* so = dir ? sob : sof;
        if (so) {
#pragma unroll
            for (int r = 0; r < C::NR; ++r)
#pragma unroll
                for (int jj = 0; jj < 4; ++jj) so[(16 * r + fq * 4 + jj) * 128 + cb + fr] = S[r][jj]; }
        if (LIGHT && wid == 0 && fr == 0) {
#pragma unroll
            for (int r = 0; r < C::NR; ++r) *(f32x4*)(dtot + dir * 128 + 16 * r + fq * 4) = Dacc[r]; }
    }
}

template <int DK, bool HG>
__device__ __forceinline__ void scan_light2(LAS unsigned char* L, const bf16_t* P, int row0, int kcol, int lfcol_f, int lfcol_b, int vcol, float* so_f, float* so_b, float* dtot) {
    constexpr int SA = DK * 2 + 32, SV = 288, NR = DK / 16, NPAIR = DK / 2;
    constexpr int OFF_L = 0, OFF_K = 128 * SA, OFF_V = 256 * SA, OFF_G = OFF_V + 128 * SV, OFF_F = OFF_G + 8 * DK * 4, OFF_T = OFF_F + DK * 4;
    static_assert(OFF_T + DK * 4 <= 147392, "LDS");
    const int tid0 = threadIdx.x;
#pragma unroll 1
    for (int dir = 0; dir < 2; ++dir) {
        const int lfcol = dir ? lfcol_b : lfcol_f;
        f32x4 S[NR];
#pragma unroll
        for (int r = 0; r < NR; ++r) S[r] = (f32x4){0.f, 0.f, 0.f, 0.f};
        u32x4 R[8];
#pragma unroll 1
        for (int st = 0; st < 2; ++st) {
            int tid = tid0; asm volatile("" : "+v"(tid));
            const int lane = tid & 63, wid = tid >> 6, fr = lane & 15, fq = lane >> 4, cb = wid * 16;
            {
                const bf16_t* pb = P + (size_t)(row0 + (dir ? 255 - 128 * st : 128 * st)) * NP;
#pragma unroll
                for (int j = 0; j < 8; ++j) {
                    int tl, col;
                    if (j >= 4) { const int p = tid + 512 * (j - 4); tl = p >> 4; col = vcol + 8 * (p & 15); }
                    else if (HG) { const int p = tid + 512 * j; tl = p >> 4; col = lfcol + 8 * (p & 15); }
                    else { const int p = tid + 512 * (j & 1); tl = p >> 3; col = (j < 2 ? lfcol : kcol) + 8 * (p & 7); }
                    R[j] = *(const u32x4*)(pb + (dir ? -tl : tl) * NP + col);
                }
            }
            __syncthreads();
#pragma unroll
            for (int j = 0; j < 8; ++j) {
                int off;
                if (j >= 4) { const int p = tid + 512 * (j - 4); off = OFF_V + (p >> 4) * SV + (p & 15) * 16; }
                else if (HG) { const int p = tid + 512 * j; off = OFF_L + (p >> 4) * SA + (p & 15) * 16; }
                else { const int p = tid + 512 * (j & 1); off = (j < 2 ? OFF_L : OFF_K) + (p >> 3) * SA + (p & 7) * 16; }
                *(LAS u32x4*)(L + off) = R[j];
            }
            __syncthreads();
            const bool act = tid < 8 * NPAIR;
            const int g = tid / NPAIR, d0 = 2 * (tid % NPAIR);
            unsigned lfv[16]; float s0 = 0.f, s1 = 0.f;
            if (act) {
#pragma unroll
                for (int i = 0; i < 16; ++i) { lfv[i] = *(const LAS unsigned*)(L + OFF_L + (16 * g + i) * SA + d0 * 2); s0 += bf_lo(lfv[i]); s1 += bf_hi(lfv[i]); }
                *(LAS f32x2_t*)(L + OFF_G + (g * DK + d0) * 4) = (f32x2_t){s0, s1};
            }
            __syncthreads();
            if (act) {
                float a0 = 0.f, a1 = 0.f;
#pragma unroll
                for (int gp = 1; gp < 8; ++gp) { const f32x2_t t = *(const LAS f32x2_t*)(L + OFF_G + (gp * DK + d0) * 4); if (gp > g) { a0 += t.x; a1 += t.y; } }
                if (g == 0) { const float t0 = s0 + a0, t1 = s1 + a1;
                    *(LAS f32x2_t*)(L + OFF_F + d0 * 4) = (f32x2_t){fast_exp(fmaxf(t0, -80.f)), fast_exp(fmaxf(t1, -80.f))};
                    LAS f32x2_t* tp = (LAS f32x2_t*)(L + OFF_T + d0 * 4); if (st == 0) *tp = (f32x2_t){t0, t1}; else { const f32x2_t o = *tp; *tp = (f32x2_t){o.x + t0, o.y + t1}; } }
#pragma unroll
                for (int i = 15; i >= 0; --i) {
                    const int o = (16 * g + i) * SA + d0 * 2;
                    float k0, k1;
                    if (HG) { k0 = 1.f - fast_exp(bf_lo(lfv[i])); k1 = 1.f - fast_exp(bf_hi(lfv[i])); }
                    else { const unsigned ku = *(const LAS unsigned*)(L + OFF_K + o); k0 = bf_lo(ku); k1 = bf_hi(ku); }
                    *(LAS unsigned*)(L + OFF_K + o) = cvtpk(k0 * fast_exp(fmaxf(a0, -80.f)), k1 * fast_exp(fmaxf(a1, -80.f)));
                    a0 += bf_lo(lfv[i]); a1 += bf_hi(lfv[i]);
                }
            }
            __syncthreads();
#pragma unroll
            for (int r = 0; r < NR; ++r) { const f32x4 fd = *(const LAS f32x4*)(L + OFF_F + (16 * r + fq * 4) * 4); S[r] = S[r] * fd; }
#pragma unroll
            for (int ks = 0; ks < 4; ++ks) {
                const int rb = 32 * ks + fq * 8 + (fr >> 2);
                const s16x4 vl = vtr(L + OFF_V + rb * SV + (cb + 4 * (fr & 3)) * 2), vh = vtr(L + OFF_V + (rb + 4) * SV + (cb + 4 * (fr & 3)) * 2);
                const bf16x8 vb = (bf16x8){vl[0], vl[1], vl[2], vl[3], vh[0], vh[1], vh[2], vh[3]};
#pragma unroll
                for (int r = 0; r < NR; ++r) {
                    const s16x4 kl = vtr(L + OFF_K + rb * SA + (16 * r + 4 * (fr & 3)) * 2), kh = vtr(L + OFF_K + (rb + 4) * SA + (16 * r + 4 * (fr & 3)) * 2);
                    const bf16x8 ka = (bf16x8){kl[0], kl[1], kl[2], kl[3], kh[0], kh[1], kh[2], kh[3]};
                    S[r] = __builtin_amdgcn_mfma_f32_16x16x32_bf16(ka, vb, S[r], 0, 0, 0);
                }
            }
            if (st == 1) {
                float* so = dir ? so_b : so_f;
#pragma unroll
                for (int r = 0; r < NR; ++r)
#pragma unroll
                    for (int jj = 0; jj < 4; ++jj) so[(16 * r + fq * 4 + jj) * 128 + cb + fr] = S[r][jj];
                if (tid < DK) dtot[dir * 128 + tid] = fast_exp(fmaxf(*(const LAS float*)(L + OFF_T + tid * 4), -80.f));
            }
        }
    }
}

__device__ __forceinline__ void phase_scan_light(const Args& a, LAS unsigned char* L) {
    const bf16_t* P = (const bf16_t*)(a.ws + WS_P);
    for (int j = blockIdx.x; j < 256; j += gridDim.x) {
        const int b = j >> 6, hh = (j >> 3) & 7, seg = j & 7, h = hh & 3, row0 = MP + b * 2048 + seg * 256;
        float* sl = (float*)(a.ws + WS_SLOC) + (size_t)j * 2 * 16384; float* dt = (float*)(a.ws + WS_DTOT) + (size_t)j * 2 * 128;
        if (hh < 4) scan_light2<64, false>(L, P, row0, 256 + h * 64, 4096 + h * 64, 4352 + h * 64, 512 + h * 128, sl, sl + 16384, dt);
        else scan_light2<128, true>(L, P, row0, 0, 2048 + h * 128, 2560 + h * 128, 3072 + h * 128, sl, sl + 16384, dt);
    }
}
__device__ __forceinline__ void phase_scan(const Args& a, LAS unsigned char* L) {
    const bf16_t* P = (const bf16_t*)(a.ws + WS_P); bf16_t* XN = (bf16_t*)(a.ws + WS_XN); float* OF = a.out;
    float* og = a.out + (size_t)MTOK * D; float* oh = og + 32 * 2 * 4 * 64 * 128;
    for (int j = blockIdx.x; j < 512; j += gridDim.x) {
        const bool samp = j >= 256; int b, hh, seg = 0, row0;
        if (samp) { const int q = j - 256;
            b = q >> 6; hh = ((((q >> 2) & 1) ^ 1) << 2) | ((q >> 3) & 3); seg = (((q >> 5) & 1) << 2) | (q & 3); row0 = MP + b * 2048 + seg * 256; } else { b = j >> 3; hh = j & 7; row0 = b * 256; }
        const int h = hh & 3;
        const int li0 = (b * 8 + hh) * 8;
        const float* cs = samp ? (const float*)(a.ws + WS_SLOC) + (size_t)li0 * 2 * 16384 : nullptr;
        const float* cd = samp ? (const float*)(a.ws + WS_DTOT) + (size_t)li0 * 2 * 128 : nullptr;
        if (hh < 4) {
            const size_t so = (size_t)(b * 2 * 4 + h) * 64 * 128, sd = (size_t)4 * 64 * 128;
            scan_item<64, false, false>(L, P, OF, XN, row0, 256, h * 64, 256 + h * 64, 4096 + h * 64, 4352 + h * 64, 512 + h * 128, 1024 + h * 128, h * 128,
                                       samp ? a.in[2] + so : nullptr, samp ? a.in[2] + so + sd : nullptr, cs, cd, seg, samp ? nullptr : og + so, samp ? nullptr : og + so + sd, nullptr, a.in[14]);
        } else {
            const size_t so = (size_t)(b * 2 * 4 + h) * 128 * 128, sd = (size_t)4 * 128 * 128;
            scan_item<128, true, false>(L, P, OF, XN, row0, 256, 1536 + h * 128, 0, 2048 + h * 128, 2560 + h * 128, 3072 + h * 128, 3584 + h * 128, 512 + h * 128,
                                       samp ? a.in[3] + so : nullptr, samp ? a.in[3] + so + sd : nullptr, cs, cd, seg, samp ? nullptr : oh + so, samp ? nullptr : oh + so + sd, nullptr, a.in[15]);
        }
    }
}

#define OPAQUE(p) asm volatile("" : "+v"(p))
template <bool GRID>
__device__ __forceinline__ void conv_load(u32x4 (&R)[GRID ? 13 : 5], u32x4 (&W)[2], const bf16_t* U, const float* cw, const float* cbias, int it, int tid) {
    constexpr int NR = GRID ? 3 : 1, NT = GRID ? 9 : 3, NPJ = GRID ? 13 : 5, TOT = NR * 66 * 32;
    const int span = it / 22, cb = it % 22;
    const bf16_t* ub = U + (size_t)span * 64 * FF2 + cb * 128; OPAQUE(ub);
#pragma unroll
    for (int j = 0; j < NPJ; ++j) {
        const int p = tid + 512 * j;
        const int rr = p / (66 * 32), rem = p % (66 * 32), s = rem >> 5, pc = rem & 31;
        bool ok; int roff;
        if (GRID) { const int r = (span & 31) + rr - 1; ok = (p < TOT) & (r >= 0) & (r < 32) & (s >= 1) & (s <= 64); roff = (rr - 1) * 64 + s - 1; }
        else { ok = (p < TOT) & (((s >= 1) & (s <= 64)) | ((s == 0) & ((span & 3) != 0)) | ((s == 65) & ((span & 3) != 3))); roff = s - 1; }
        const int off = ok ? roff * FF2 + (pc < 16 ? pc * 8 : FF + (pc - 16) * 8) : 0;
        u32x4 v = *(const u32x4*)(ub + off);
        const unsigned m = ok ? 0xffffffffu : 0u;
        v.x &= m; v.y &= m; v.z &= m; v.w &= m;
        R[j] = v;
    }
#pragma unroll
    for (int j = 0; j < 2; ++j) {
        const int p = tid + 512 * j;
        const bool isw = p < NT * 64; const int q = isw ? p : (p < NT * 64 + 64 ? p - NT * 64 : 0);
        const int tap = q >> 6, g = (q >> 5) & 1, c4 = q & 31;
        const float* src = isw ? cw + (size_t)(GRID ? tap : 3 + tap) * FF2 : cbias;
        W[j] = *(const u32x4*)(src + g * FF + cb * 128 + c4 * 4);
    }
}
__device__ __forceinline__ void conv_fma(float (&ag)[8], float (&au)[8], const u32x4 gv, const u32x4 uv, const LAS float* wg) {
    const f32x4 wg0 = *(const LAS f32x4*)wg, wg1 = *(const LAS f32x4*)(wg + 4), wu0 = *(const LAS f32x4*)(wg + 128), wu1 = *(const LAS f32x4*)(wg + 132);
    ag[0] += bf_lo(gv[0]) * wg0[0]; ag[1] += bf_hi(gv[0]) * wg0[1]; ag[2] += bf_lo(gv[1]) * wg0[2]; ag[3] += bf_hi(gv[1]) * wg0[3];
    ag[4] += bf_lo(gv[2]) * wg1[0]; ag[5] += bf_hi(gv[2]) * wg1[1]; ag[6] += bf_lo(gv[3]) * wg1[2]; ag[7] += bf_hi(gv[3]) * wg1[3];
    au[0] += bf_lo(uv[0]) * wu0[0]; au[1] += bf_hi(uv[0]) * wu0[1]; au[2] += bf_lo(uv[1]) * wu0[2]; au[3] += bf_hi(uv[1]) * wu0[3];
    au[4] += bf_lo(uv[2]) * wu1[0]; au[5] += bf_hi(uv[2]) * wu1[1]; au[6] += bf_lo(uv[3]) * wu1[2]; au[7] += bf_hi(uv[3]) * wu1[3];
}
template <bool GRID>
__device__ __forceinline__ void phase_conv(const Args& a, LAS unsigned char* L, const bf16_t* U, bf16_t* Aff) {
    constexpr int NR = GRID ? 3 : 1, NT = GRID ? 9 : 3, NPJ = GRID ? 13 : 5, TOT = NR * 66 * 32;
    constexpr int ROWB = 66 * 512, OFF_W = NR * ROWB;
    const float* cw = a.in[18]; const float* cbias = a.in[19];
    const int tid0 = threadIdx.x;
    u32x4 R[NPJ], W[2];
    int it = blockIdx.x;
#pragma unroll 1
    for (; it < 128 * 22; it += gridDim.x) {
        int tid = tid0; asm volatile("" : "+v"(tid));
        const int cgl = tid & 15, tp = tid >> 4;
        conv_load<GRID>(R, W, U, cw, cbias, it, tid);
        __syncthreads();
#pragma unroll
        for (int j = 0; j < NPJ; ++j) { const int p = tid + 512 * j; if (p < TOT) *(LAS u32x4*)(L + p * 16) = R[j]; }
#pragma unroll
        for (int j = 0; j < 2; ++j) { const int p = tid + 512 * j; if (p < NT * 64 + 64) *(LAS u32x4*)(L + OFF_W + p * 16) = W[j]; }
        const int span = it / 22, cb = it % 22;
        __syncthreads();
        float ag[2][8], au[2][8];
        { const LAS float* bl = (const LAS float*)(L + OFF_W + NT * 1024);
          const f32x4 g0 = *(const LAS f32x4*)(bl + cgl * 8), g1 = *(const LAS f32x4*)(bl + cgl * 8 + 4), u0 = *(const LAS f32x4*)(bl + 128 + cgl * 8), u1 = *(const LAS f32x4*)(bl + 128 + cgl * 8 + 4);
#pragma unroll
          for (int t = 0; t < 2; ++t)
#pragma unroll
              for (int e = 0; e < 4; ++e) { ag[t][e] = g0[e]; ag[t][4 + e] = g1[e]; au[t][e] = u0[e]; au[t][4 + e] = u1[e]; } }
#pragma unroll 1
        for (int rr = 0; rr < NR; ++rr) {
#pragma unroll
            for (int cs = 0; cs < 4; ++cs) {
                const LAS unsigned char* tp_ = L + rr * ROWB + (2 * tp + cs) * 512 + cgl * 16;
                const u32x4 gv = *(const LAS u32x4*)tp_, uv = *(const LAS u32x4*)(tp_ + 256);
                if (cs <= 2) conv_fma(ag[0], au[0], gv, uv, (const LAS float*)(L + OFF_W) + (rr * 3 + cs) * 256 + cgl * 8);
                if (cs >= 1) conv_fma(ag[1], au[1], gv, uv, (const LAS float*)(L + OFF_W) + (rr * 3 + cs - 1) * 256 + cgl * 8);
            }
        }
#pragma unroll
        for (int t = 0; t < 2; ++t) {
            u32x4 o;
            o.x = cvtpk(silu_f(ag[t][0]) * au[t][0], silu_f(ag[t][1]) * au[t][1]); o.y = cvtpk(silu_f(ag[t][2]) * au[t][2], silu_f(ag[t][3]) * au[t][3]);
            o.z = cvtpk(silu_f(ag[t][4]) * au[t][4], silu_f(ag[t][5]) * au[t][5]); o.w = cvtpk(silu_f(ag[t][6]) * au[t][6], silu_f(ag[t][7]) * au[t][7]);
            *(u32x4*)(Aff + (size_t)(span * 64 + 2 * tp + t) * FF + cb * 128 + cgl * 8) = o;
        }
    }
}

__device__ __forceinline__ void conv_fma64(float (&ag)[8], float (&au)[8], const float (&g)[8], const float (&u)[8], const LAS float* wg) {
    const f32x4 wg0 = *(const LAS f32x4*)wg, wg1 = *(const LAS f32x4*)(wg + 4), wu0 = *(const LAS f32x4*)(wg + 64), wu1 = *(const LAS f32x4*)(wg + 68);
#pragma unroll
    for (int e = 0; e < 4; ++e) { ag[e] += g[e] * wg0[e]; ag[4 + e] += g[4 + e] * wg1[e]; au[e] += u[e] * wu0[e]; au[4 + e] += u[4 + e] * wu1[e]; }
}
__device__ __forceinline__ void phase_conv_grid4(const Args& a, LAS unsigned char* L, const bf16_t* U, bf16_t* Aff) {
    constexpr int ROWB = 66 * 256, TOT = 6 * 66 * 16, OFF_W = 6 * ROWB, NIT = 32 * 44;
    const float* cw = a.in[18]; const float* cbias = a.in[19];
    const int tid0 = threadIdx.x;
#pragma unroll 1
    for (int it = blockIdx.x; it < NIT; it += gridDim.x) {
        int tid = tid0; asm volatile("" : "+v"(tid));
        const int q4 = it / 44, cb = it % 44, batch = q4 >> 3, r0 = (q4 & 7) * 4;
        u32x4 R[13], W;
        { const bf16_t* ub = U + (size_t)(batch * 2048 + r0 * 64) * FF2 + cb * 64;
#pragma unroll
          for (int j = 0; j < 13; ++j) {
              const int p = tid + 512 * j;
              const int rr = p / 1056, rem = p % 1056, sl = rem >> 4, pc = rem & 15, r = r0 + rr - 1;
              const bool ok = (p < TOT) & (r >= 0) & (r < 32) & (sl >= 1) & (sl <= 64);
              const int off = ok ? ((rr - 1) * 64 + sl - 1) * FF2 + (pc < 8 ? pc * 8 : FF + (pc - 8) * 8) : 0;
              u32x4 v = *(const u32x4*)(ub + (ok ? off : 64 * FF2));
              const unsigned m = ok ? 0xffffffffu : 0u; v.x &= m; v.y &= m; v.z &= m; v.w &= m; R[j] = v; }
          const int p = tid < 320 ? tid : 0; const bool isw = p < 288; const int qq = isw ? p : p - 288;
          const int tap = qq >> 5, g = (qq >> 4) & 1, c4 = qq & 15;
          W = *(const u32x4*)((isw ? cw + (size_t)tap * FF2 : cbias) + g * FF + cb * 64 + c4 * 4); }
        __syncthreads();
#pragma unroll
        for (int j = 0; j < 13; ++j) { const int p = tid + 512 * j; if (p < TOT) *(LAS u32x4*)(L + p * 16) = R[j]; }
        if (tid < 320) *(LAS u32x4*)(L + OFF_W + tid * 16) = W;
        __syncthreads();
        const int cgl = tid & 7, w = tid >> 3;
        float ag[4][8], au[4][8];
        { const LAS float* bl = (const LAS float*)(L + OFF_W + 9 * 512);
          const f32x4 g0 = *(const LAS f32x4*)(bl + cgl * 8), g1 = *(const LAS f32x4*)(bl + cgl * 8 + 4), u0 = *(const LAS f32x4*)(bl + 64 + cgl * 8), u1 = *(const LAS f32x4*)(bl + 64 + cgl * 8 + 4);
#pragma unroll
          for (int t = 0; t < 4; ++t)
#pragma unroll
              for (int e = 0; e < 4; ++e) { ag[t][e] = g0[e]; ag[t][4 + e] = g1[e]; au[t][e] = u0[e]; au[t][4 + e] = u1[e]; } }
#pragma unroll 1
        for (int kw = 0; kw < 3; ++kw) {
#pragma unroll
            for (int rr = 0; rr < 6; ++rr) {
                const LAS unsigned char* tp_ = L + rr * ROWB + (w + kw) * 256 + cgl * 16;
                const u32x4 gv = *(const LAS u32x4*)tp_, uv = *(const LAS u32x4*)(tp_ + 128);
                float g[8], u[8];
#pragma unroll
                for (int e = 0; e < 4; ++e) { g[2 * e] = bf_lo(gv[e]); g[2 * e + 1] = bf_hi(gv[e]); u[2 * e] = bf_lo(uv[e]); u[2 * e + 1] = bf_hi(uv[e]); }
#pragma unroll
                for (int kh = 0; kh < 3; ++kh) { const int ro = rr - kh; if (ro >= 0 && ro <= 3) conv_fma64(ag[ro], au[ro], g, u, (const LAS float*)(L + OFF_W) + (kh * 3 + kw) * 128 + cgl * 8); }
            }
        }
#pragma unroll
        for (int t = 0; t < 4; ++t) {
            u32x4 o;
            o.x = cvtpk(silu_f(ag[t][0]) * au[t][0], silu_f(ag[t][1]) * au[t][1]); o.y = cvtpk(silu_f(ag[t][2]) * au[t][2], silu_f(ag[t][3]) * au[t][3]);
            o.z = cvtpk(silu_f(ag[t][4]) * au[t][4], silu_f(ag[t][5]) * au[t][5]); o.w = cvtpk(silu_f(ag[t][6]) * au[t][6], silu_f(ag[t][7]) * au[t][7]);
            *(u32x4*)(Aff + (size_t)(batch * 2048 + (r0 + t) * 64 + w) * FF + cb * 64 + cgl * 8) = o;
        }
    }
}

__device__ __forceinline__ void conv_seq_load(u32x4 (&R)[8], u32x4& W, const bf16_t* U, const float* cw, const float* cbias, int it, int tid) {
    const int b = it / 44, cb = it % 44;
        { const bf16_t* ub = U + (size_t)b * 256 * FF2 + cb * 64;
#pragma unroll
          for (int j = 0; j < 8; ++j) { const int p = tid + 512 * j, t = p >> 4, pc = p & 15; R[j] = *(const u32x4*)(ub + (size_t)t * FF2 + (pc < 8 ? pc * 8 : FF + (pc - 8) * 8)); }
          const int p = tid < 128 ? tid : 0; const bool isw = p < 96; const int qq = isw ? p : p - 96;
          const int tap = qq >> 5, g = (qq >> 4) & 1, c4 = qq & 15;
          W = *(const u32x4*)((isw ? cw + (size_t)tap * FF2 : cbias) + g * FF + cb * 64 + c4 * 4); }
}
__device__ __forceinline__ void phase_conv_seq(const Args& a, LAS unsigned char* L, const bf16_t* U, bf16_t* Aff) {
    constexpr int OFF_W = 258 * 256, NIT = 32 * 44;
    const float* cw = a.in[18] + 3 * FF2; const float* cbias = a.in[19];
    const int tid0 = threadIdx.x;
    __syncthreads();
    if (tid0 < 32) { const int side = tid0 >> 4, pc = tid0 & 15; *(LAS u32x4*)(L + (side ? 257 : 0) * 256 + pc * 16) = (u32x4){0u, 0u, 0u, 0u}; }
    u32x4 R[8], W;
    if ((int)blockIdx.x < NIT) conv_seq_load(R, W, U, cw, cbias, blockIdx.x, tid0);
#pragma unroll 1
    for (int it = blockIdx.x; it < NIT; it += gridDim.x) {
        int tid = tid0; asm volatile("" : "+v"(tid));
        const int b = it / 44, cb = it % 44;
        __syncthreads();
#pragma unroll
        for (int j = 0; j < 8; ++j) { const int p = tid + 512 * j; *(LAS u32x4*)(L + 256 + p * 16) = R[j]; }
        if (tid < 128) *(LAS u32x4*)(L + OFF_W + tid * 16) = W;
        if (it + (int)gridDim.x < NIT) conv_seq_load(R, W, U, cw, cbias, it + gridDim.x, tid);
        __syncthreads();
        const int cgl = tid & 7, tq = tid >> 3;
        float ag[4][8], au[4][8];
        { const LAS float* bl = (const LAS float*)(L + OFF_W + 3 * 512);
          const f32x4 g0 = *(const LAS f32x4*)(bl + cgl * 8), g1 = *(const LAS f32x4*)(bl + cgl * 8 + 4), u0 = *(const LAS f32x4*)(bl + 64 + cgl * 8), u1 = *(const LAS f32x4*)(bl + 64 + cgl * 8 + 4);
#pragma unroll
          for (int t = 0; t < 4; ++t)
#pragma unroll
              for (int e = 0; e < 4; ++e) { ag[t][e] = g0[e]; ag[t][4 + e] = g1[e]; au[t][e] = u0[e]; au[t][4 + e] = u1[e]; } }
#pragma unroll
        for (int cs = 0; cs < 6; ++cs) {
            const LAS unsigned char* tp_ = L + (4 * tq + cs) * 256 + cgl * 16;
            const u32x4 gv = *(const LAS u32x4*)tp_, uv = *(const LAS u32x4*)(tp_ + 128);
            float g[8], u[8];
#pragma unroll
            for (int e = 0; e < 4; ++e) { g[2 * e] = bf_lo(gv[e]); g[2 * e + 1] = bf_hi(gv[e]); u[2 * e] = bf_lo(uv[e]); u[2 * e + 1] = bf_hi(uv[e]); }
#pragma unroll
            for (int t = 0; t < 4; ++t) { const int kw = cs - t; if (kw >= 0 && kw <= 2) conv_fma64(ag[t], au[t], g, u, (const LAS float*)(L + OFF_W) + kw * 128 + cgl * 8); }
        }
#pragma unroll
        for (int t = 0; t < 4; ++t) {
            u32x4 o;
            o.x = cvtpk(silu_f(ag[t][0]) * au[t][0], silu_f(ag[t][1]) * au[t][1]); o.y = cvtpk(silu_f(ag[t][2]) * au[t][2], silu_f(ag[t][3]) * au[t][3]);
            o.z = cvtpk(silu_f(ag[t][4]) * au[t][4], silu_f(ag[t][5]) * au[t][5]); o.w = cvtpk(silu_f(ag[t][6]) * au[t][6], silu_f(ag[t][7]) * au[t][7]);
            *(u32x4*)(Aff + (size_t)(b * 256 + 4 * tq + t) * FF + cb * 64 + cgl * 8) = o;
        }
    }
}

#define XB_TMO      128
#define XB_XCNT(j)  (256  + 64 * (j))
#define XB_XSUB(j)  (1280 + 64 * (j))
#define XB_XGEN(j)  (2304 + 64 * (j))
#define XB_TOP      3328
#define XB_TOPGEN   3392
#define XCD_BAR_WORDS 3456
#define XB_SPIN_CAP (1u << 18)

__device__ __forceinline__ unsigned xb_ld(unsigned* p)              { return __hip_atomic_load(p, __ATOMIC_RELAXED, __HIP_MEMORY_SCOPE_AGENT); }
__device__ __forceinline__ unsigned xb_add(unsigned* p, unsigned v) { return __hip_atomic_fetch_add(p, v, __ATOMIC_RELAXED, __HIP_MEMORY_SCOPE_AGENT); }
__device__ __forceinline__ unsigned xb_xcc_id() { return (unsigned)__builtin_amdgcn_s_getreg((3 << 11) | 20) & 0xFu; }
#define XB_SPIN(cond, bar) do { unsigned _sp = 0; while (cond) { __builtin_amdgcn_s_sleep(1); \
    if ((++_sp & 255u) == 0u) { if (xb_ld(&(bar)[XB_TMO])) break; if (_sp > XB_SPIN_CAP) { atomicAdd(&(bar)[XB_TMO], 1u); break; } } } } while (0)

struct XcdBarrier {
    unsigned* bar; unsigned x;
    volatile LAS unsigned* st;
};

__device__ __forceinline__ XcdBarrier xcd_barrier_post(unsigned* bar, volatile LAS unsigned* st) {
    XcdBarrier b; b.bar = bar; b.x = xb_xcc_id(); b.st = st;
    if (threadIdx.x == 0) (void)xb_add(&bar[XB_XCNT(b.x)], 1u);
    return b;
}
__device__ __forceinline__ void xcd_barrier_complete(unsigned* bar, unsigned x, unsigned& nloc, unsigned& nx) {
    const unsigned G = gridDim.x * gridDim.y * gridDim.z;
    unsigned sum, cnt, mine, sp = 0u;
    for (;;) {
        sum = 0u; cnt = 0u; mine = 0u;
#pragma unroll
        for (unsigned j = 0; j < 16; ++j) { const unsigned c = xb_ld(&bar[XB_XCNT(j)]); sum += c; cnt += (c > 0u) ? 1u : 0u; mine = (j == x) ? c : mine; }
        if (sum == G) break;
        __builtin_amdgcn_s_sleep(1);
        if ((++sp & 255u) == 0u) { if (xb_ld(&bar[XB_TMO])) break; if (sp > XB_SPIN_CAP) { atomicAdd(&bar[XB_TMO], 1u); break; } }
    }
    nloc = mine > 0u ? mine : 1u; nx = cnt > 0u ? cnt : 1u;
}

__device__ __forceinline__ void xcd_barrier(const XcdBarrier& b) {
    asm volatile("s_waitcnt vmcnt(0)" ::: "memory");
    __syncthreads();
    if (threadIdx.x == 0) {
        unsigned* bar = b.bar;
        __builtin_amdgcn_s_waitcnt(0);
        unsigned nloc = b.st[0], nx = b.st[1];
        if (nloc == 0u) { xcd_barrier_complete(bar, b.x, nloc, nx); b.st[0] = nloc; b.st[1] = nx; }
        const unsigned old = xb_add(&bar[XB_XSUB(b.x)], 1u);
        const unsigned gen = old / nloc;
        if (old + 1u == (gen + 1u) * nloc) {
            __builtin_amdgcn_fence(__ATOMIC_RELEASE, "agent");
            asm volatile("s_waitcnt vmcnt(0)" ::: "memory");
            const unsigned og = xb_add(&bar[XB_TOP], 1u);
            const unsigned tg = og / nx;
            if (og + 1u == (tg + 1u) * nx) xb_add(&bar[XB_TOPGEN], 1u);
            else XB_SPIN(xb_ld(&bar[XB_TOPGEN]) == tg, bar);
            __builtin_amdgcn_fence(__ATOMIC_ACQUIRE, "agent");
            xb_add(&bar[XB_XGEN(b.x)], 1u);
            asm volatile("s_waitcnt vmcnt(0)" ::: "memory");
        } else {
            XB_SPIN(xb_ld(&bar[XB_XGEN(b.x)]) == gen, bar);
            __builtin_amdgcn_fence(__ATOMIC_ACQUIRE, "agent");
            asm volatile("s_waitcnt vmcnt(0)" ::: "memory");
        }
    }
    __syncthreads();
}

__device__ __forceinline__ Args load_args() {
    Args r{};
#if defined(__HIP_DEVICE_COMPILE__)
    typedef __attribute__((address_space(4))) const Args* CArgs;
    CArgs q = (CArgs)__builtin_amdgcn_kernarg_segment_ptr(); asm volatile("" : "+s"(q));
#pragma unroll
    for (int i = 0; i < 22; ++i) r.in[i] = q->in[i];
    r.out = q->out; r.ws = q->ws; r.ph_lo = q->ph_lo; r.ph_hi = q->ph_hi;
#endif
    return r;
}
__global__ void __launch_bounds__(512, 2) fwd_mega(Args a_unused) {
    extern __shared__ __attribute__((aligned(16))) unsigned char lds_raw[];
    LAS unsigned char* L = (LAS unsigned char*)lds_raw;
    cg::grid_group grid = cg::this_grid();
    int lo, hi; unsigned* barw; { const Args a0 = load_args(); lo = a0.ph_lo; hi = a0.ph_hi; barw = (unsigned*)(a0.ws + WS_BAR); }
    if (threadIdx.x < 2) ((volatile LAS unsigned*)(L + LDS_MISC))[threadIdx.x] = 0u;
    __syncthreads();
    const XcdBarrier bar = xcd_barrier_post(barw, (volatile LAS unsigned*)(L + LDS_MISC));
    if (hi > 1000) grid.sync();
#define PHASE_VARS const Args a = load_args(); unsigned char* ws = a.ws; bf16_t* XN = (bf16_t*)(ws + WS_XN); const float* mod = (const float*)(ws + WS_MOD); (void)XN; (void)mod;
#define IN(k) (lo <= (k) && (k) < hi)
#define SEAM(k) do { if (IN(k) && IN((k) + 1)) xcd_barrier(bar); } while (0)
    if (IN(0)) { PHASE_VARS phase_prep(a, L); } SEAM(0);
    if (IN(1)) { PHASE_VARS phase_norm1(a, L, XN); } SEAM(1);
    if (IN(2)) { PHASE_VARS pg8::Gemm g{XN, (const bf16_t*)(ws + WS_WIN), MTOK, NP, D}; pg8::StaticOrder S; S.init(MTOK, NP, gridDim.x, blockIdx.x);
        pg8::EpiProj E{(bf16_t*)(ws + WS_P), (const float*)(ws + WS_C0), (const float*)(ws + WS_C1)};
        pg8::gemm_phase<pg8::EpiProj, pg8::StaticOrder, true, true>(L, g, S, E);
        if (gridDim.x == 256 && blockIdx.x >= 128) phase_prep_late(a, L, 128); else if (gridDim.x != 256) phase_prep_late(a, L, 0); } SEAM(2);
    if (IN(3)) { PHASE_VARS phase_scan_light(a, L); } SEAM(3);
    if (IN(4)) { PHASE_VARS phase_scan(a, L); } SEAM(4);
    if (IN(5)) { PHASE_VARS pg8::Gemm g{XN, (const bf16_t*)(ws + WS_WO), MTOK, D, D}; pg8::StaticOrder S; S.init(MTOK, D, gridDim.x, blockIdx.x);
        pg8::EpiResNorm<false> E{a.in[0], a.in[1], a.out, mod, 2048, 3072, 4096, a.in[9], XN, (float*)(ws + WS_SLOTS), (unsigned*)(ws + WS_CNT)};
        pg8::gemm_phase<pg8::EpiResNorm<false>, pg8::StaticOrder, true, true>(L, g, S, E); } SEAM(5);
    if (IN(6)) { PHASE_VARS pg8::Gemm g{XN, (const bf16_t*)(ws + WS_WUP), MP, FF2, D}; pg8::StaticOrder S; S.init(MP, FF2, gridDim.x, blockIdx.x);
        pg8::EpiPlain E{(bf16_t*)(ws + WS_U), FF2};
        pg8::gemm_phase<pg8::EpiPlain, pg8::StaticOrder, true, true>(L, g, S, E); } SEAM(6);
    if (IN(7)) { PHASE_VARS phase_conv_seq(a, L, (const bf16_t*)(ws + WS_U), (bf16_t*)(ws + WS_AFF)); } SEAM(7);
    if (IN(8)) { PHASE_VARS pg8::Gemm g{XN + (size_t)MP * D, (const bf16_t*)(ws + WS_WUP), MP, FF2, D}; pg8::StaticOrder S; S.init(MP, FF2, gridDim.x, blockIdx.x);
        pg8::EpiPlain E{(bf16_t*)(ws + WS_U), FF2};
        pg8::gemm_phase<pg8::EpiPlain, pg8::StaticOrder, true, true>(L, g, S, E); } SEAM(8);
    if (IN(9)) { PHASE_VARS phase_conv_grid4(a, L, (const bf16_t*)(ws + WS_U), (bf16_t*)(ws + WS_AFF) + (size_t)MP * FF); } SEAM(9);
    if (IN(10)) { PHASE_VARS pg8::Gemm g{(const bf16_t*)(ws + WS_AFF), (const bf16_t*)(ws + WS_WDN), MTOK, D, FF}; pg8::StaticOrder S; S.init(MTOK, D, gridDim.x, blockIdx.x);
        pg8::EpiResNorm<true> E{a.out, a.out + (size_t)MP * D, a.out, mod, 5120, 0, 0, a.in[21], nullptr, (float*)(ws + WS_SLOTS) + (size_t)MTOK * 4, (unsigned*)(ws + WS_CNT) + 64 * 64};
        pg8::gemm_phase<pg8::EpiResNorm<true>, pg8::StaticOrder, true, true>(L, g, S, E); } SEAM(10);
#undef IN
#undef SEAM
}

extern "C" void kernel_launch(void* const* d_in, const int* in_sizes, int n_in, void* d_out, int out_size, void* d_ws, size_t ws_size, hipStream_t stream) {
    static int grid = 0;
    if (grid == 0) {
        if (n_in != 22 || ws_size < WS_END) { fprintf(stderr, "kernel_launch: unexpected n_in %d / ws %zu\n", n_in, ws_size); grid = -1; return; }
        int dev = 0, cus = 0, per_cu = 0;
        (void)hipGetDevice(&dev); (void)hipDeviceGetAttribute(&cus, hipDeviceAttributeMultiprocessorCount, dev);
        if (hipFuncSetAttribute((const void*)fwd_mega, hipFuncAttributeMaxDynamicSharedMemorySize, LDS_BYTES) != hipSuccess) { fprintf(stderr, "hipFuncSetAttribute failed\n"); grid = -1; return; }
        if (hipOccupancyMaxActiveBlocksPerMultiprocessor(&per_cu, (const void*)fwd_mega, 512, LDS_BYTES) != hipSuccess || per_cu < 1) { fprintf(stderr, "occupancy query: %d\n", per_cu); grid = -1; return; }
        grid = cus;
        if (grid != 256) { fprintf(stderr, "kernel_launch: built for a 256-CU device (grid %d)\n", grid); grid = -1; return; }
    }
    if (grid < 0) return;
    if (hipMemsetAsync((char*)d_ws + WS_BAR, 0, 16384, stream) != hipSuccess) { fprintf(stderr, "kernel_launch: hipMemsetAsync failed\n"); return; }
    Args a{};
    for (int i = 0; i < 22; ++i) a.in[i] = (const float*)d_in[i];
    a.out = (float*)d_out; a.ws = (unsigned char*)d_ws;
#if MK_MULTI
    for (int p = 0; p < NPH; ++p) { a.ph_lo = p; a.ph_hi = p + 1; hipLaunchKernelGGL(fwd_mega, dim3(grid), dim3(512), LDS_BYTES, stream, a); }
#else
    a.ph_lo = 0; a.ph_hi = NPH;
    void* args[] = {&a};
    hipError_t e = hipLaunchCooperativeKernel((const void*)fwd_mega, dim3(grid), dim3(512), args, LDS_BYTES, stream);
    if (e != hipSuccess) fprintf(stderr, "cooperative launch failed: %s (grid %d)\n", hipGetErrorString(e), grid);
#endif
}
```
